# Optimizing an MI355X kernel written in HIP

```python
import math
import jax, jax.numpy as jnp
from jax import lax
import numpy as np

D_MODEL = 1024
BATCH = 8
SEQ = 2048
DEPTH = 2

GRID_W = 64
CTX_LEN = 256
N_MIXERS = 2
N_ATTN_LAYERS = (DEPTH + N_MIXERS - 1) // N_MIXERS
N_HGRN_LAYERS = DEPTH // N_MIXERS
DA_HEADS = 8
DA_QK_DIM = D_MODEL // (2 * DA_HEADS)
DA_V_DIM = 2 * DA_QK_DIM
ROPE_BASE = 10000.0
Q_BLOCK = 128
HG_HEADS = 8
HG_DIM = D_MODEL // HG_HEADS
CHUNK = 64
N_EXPERTS = 16
N_GROUPS = 4
EXPERTS_PER_GROUP = N_EXPERTS // N_GROUPS
TOP_K = 2
D_FF = D_MODEL // 2
EPS = 1e-6

kernel_name = "hybrid_diffattn_hgrn2_groupmoe_dit"


def rms_norm(x, g):
    xf = x.astype(jnp.float32)
    y = xf * lax.rsqrt(jnp.mean(xf * xf, axis=-1, keepdims=True) + EPS)
    return (y * g.astype(jnp.float32)).astype(x.dtype)


def axial_rope_tables(n_tokens):
    rows = n_tokens // GRID_W
    r, col = jnp.meshgrid(jnp.arange(rows), jnp.arange(GRID_W), indexing="ij")
    r = r.reshape(-1).astype(jnp.float32)
    col = col.reshape(-1).astype(jnp.float32)
    n_pairs = DA_QK_DIM // 4
    inv = ROPE_BASE ** (-jnp.arange(n_pairs, dtype=jnp.float32) / n_pairs)
    ang = jnp.concatenate([r[:, None] * inv, col[:, None] * inv], axis=-1)
    return jnp.cos(ang), jnp.sin(ang)


def apply_rope(x, cos, sin):
    xf = x.astype(jnp.float32)
    half = xf.shape[-1] // 2
    x1, x2 = xf[..., :half], xf[..., half:]
    cs, sn = cos[None, :, None, None, :], sin[None, :, None, None, :]
    return jnp.concatenate([x1 * cs - x2 * sn, x2 * cs + x1 * sn], axis=-1).astype(x.dtype)


def diff_attention_mixer(h, hc, w_qkv, w_o, q_norm, k_norm, sub_norm, lam_p, layer_idx, need_ctx_out):
    B, T, _ = h.shape
    lam_init = 0.8 - 0.6 * math.exp(-0.3 * layer_idx)
    lp = lam_p.astype(jnp.float32)
    lam = jnp.exp(jnp.sum(lp[0] * lp[1])) - jnp.exp(jnp.sum(lp[2] * lp[3])) + lam_init
    scale = 1.0 / math.sqrt(DA_QK_DIM)

    def project(t):
        b_, t_, _ = t.shape
        q, k, v = jnp.split(t @ w_qkv, 3, axis=-1)
        q = rms_norm(q.reshape(b_, t_, DA_HEADS, 2, DA_QK_DIM), q_norm)
        k = rms_norm(k.reshape(b_, t_, DA_HEADS, 2, DA_QK_DIM), k_norm)
        return q, k, v.reshape(b_, t_, DA_HEADS, DA_V_DIM)

    def attend(qb, keys, vals):
        s = jnp.einsum("bqhmd,bkhmd->bhmqk", qb.astype(jnp.float32), keys.astype(jnp.float32)) * scale
        p = jax.nn.softmax(s, axis=-1)
        a = p[:, :, 0] - lam * p[:, :, 1]
        return jnp.einsum("bhqk,bkhe->bqhe", a, vals.astype(jnp.float32))

    def head_out(o):
        o = rms_norm(o, sub_norm) * (1.0 - lam_init)
        return o.reshape(o.shape[0], o.shape[1], DA_HEADS * DA_V_DIM).astype(h.dtype) @ w_o

    q, k, v = project(h)
    cos, sin = axial_rope_tables(T)
    q, k = apply_rope(q, cos, sin), apply_rope(k, cos, sin)
    qc, kc, vc = project(hc)

    k_all = jnp.concatenate([k, kc], axis=1)
    v_all = jnp.concatenate([v, vc], axis=1)
    nb = T // Q_BLOCK
    q_blocks = q.reshape(B, nb, Q_BLOCK, DA_HEADS, 2, DA_QK_DIM).swapaxes(0, 1)
    o = lax.map(lambda qb: attend(qb, k_all, v_all), q_blocks)
    out = head_out(o.swapaxes(0, 1).reshape(B, T, DA_HEADS, DA_V_DIM))
    out_c = head_out(attend(qc, kc, vc)) if need_ctx_out else None
    return out, out_c


def gla_chunk_scan(q, k, v, logf, s0):
    B, T, H, K = q.shape
    V = v.shape[-1]
    n = T // CHUNK

    def to_chunks(t):
        return t.reshape(B, n, CHUNK, H, t.shape[-1]).swapaxes(0, 1)

    mask = jnp.tril(jnp.ones((CHUNK, CHUNK), dtype=bool))[None, :, :, None, None]

    def step(S, xs):
        qc, kc, vc, lf = xs
        b = jnp.cumsum(lf, axis=1)
        o_inter = jnp.einsum("bchk,bhkv->bchv", qc * jnp.exp(b), S)
        rel = b[:, :, None] - b[:, None, :]
        decay = jnp.where(mask, jnp.exp(jnp.where(mask, rel, 0.0)), 0.0)
        scores = jnp.einsum("bthk,bshk,btshk->bhts", qc, kc, decay)
        o_intra = jnp.einsum("bhts,bshv->bthv", scores, vc)
        b_last = b[:, -1]
        S_new = jnp.exp(b_last)[..., None] * S + jnp.einsum(
            "bshk,bshv->bhkv", kc * jnp.exp(b_last[:, None] - b), vc)
        return S_new, o_inter + o_intra

    S_fin, o = lax.scan(step, s0, (to_chunks(q), to_chunks(k), to_chunks(v), to_chunks(logf)))
    return o.swapaxes(0, 1).reshape(B, T, H, V), S_fin


def hgrn2_mixer(h, hc, w_in, w_o, out_norm, lb, need_ctx_out):
    lb = lb.astype(jnp.float32)

    def project(t):
        b_, t_, _ = t.shape
        q, v, zf, zb, g = jnp.split(t @ w_in, 5, axis=-1)
        shp = (b_, t_, HG_HEADS, HG_DIM)
        q = jax.nn.silu(q.astype(jnp.float32)).reshape(shp)
        v = v.astype(jnp.float32).reshape(shp)
        zf = zf.astype(jnp.float32).reshape(shp)
        zb = zb.astype(jnp.float32).reshape(shp)
        return q, v, zf, zb, g.astype(jnp.float32).reshape(shp)

    def forget(z, lbd):
        logf = jnp.logaddexp(jnp.log(lbd), jnp.log1p(-lbd) + jax.nn.log_sigmoid(z))
        return (1.0 - lbd) * jax.nn.sigmoid(-z), logf

    def flip(t):
        return jnp.flip(t, axis=1)

    def bidir(q, v, zf, zb, s_f, s_b):
        kf, lff = forget(zf, lb[0])
        kb, lfb = forget(zb, lb[1])
        o_f, S_f = gla_chunk_scan(q, kf, v, lff, s_f)
        o_b, S_b = gla_chunk_scan(flip(q), flip(kb), flip(v), flip(lfb), s_b)
        return o_f + flip(o_b), S_f, S_b

    def readout(o, g):
        o = rms_norm(o, out_norm) * jax.nn.silu(g)
        return o.reshape(o.shape[0], o.shape[1], HG_HEADS * HG_DIM).astype(h.dtype) @ w_o

    qc, vc, zfc, zbc, gc = project(hc)
    s0 = jnp.zeros((hc.shape[0], HG_HEADS, HG_DIM, HG_DIM), jnp.float32)
    oc, Sc_f, Sc_b = bidir(qc, vc, zfc, zbc, s0, s0)
    q, v, zf, zb, g = project(h)
    o, _, _ = bidir(q, v, zf, zb, Sc_f, Sc_b)
    out_c = readout(oc, gc) if need_ctx_out else None
    return readout(o, g), out_c


def moe_ffn(t, router_w, router_bias, w_gate, w_up, w_down):
    n = t.shape[0]
    aff = jax.nn.sigmoid(t.astype(jnp.float32) @ router_w.astype(jnp.float32))
    biased = aff + router_bias.astype(jnp.float32)
    grp_score = lax.top_k(biased.reshape(n, N_GROUPS, EXPERTS_PER_GROUP), TOP_K)[0].sum(-1)
    sel_group = jnp.argmax(grp_score, axis=-1)
    in_group = (jnp.arange(N_EXPERTS) // EXPERTS_PER_GROUP)[None, :] == sel_group[:, None]
    _, idx = lax.top_k(jnp.where(in_group, biased, -jnp.inf), TOP_K)
    w = jnp.take_along_axis(aff, idx, axis=-1)
    w = w / jnp.sum(w, axis=-1, keepdims=True)
    gates = jnp.sum(jax.nn.one_hot(idx, N_EXPERTS, dtype=jnp.float32) * w[..., None], axis=1)
    y = jnp.zeros((n, t.shape[1]), jnp.float32)
    for e in range(N_EXPERTS):
        hid = jax.nn.silu(t @ w_gate[e]) * (t @ w_up[e])
        y = y + gates[:, e:e + 1] * (hid @ w_down[e]).astype(jnp.float32)
    return y.astype(t.dtype)


def setup_inputs(seed: int = 0) -> dict:
    key = jax.random.key(seed)
    ks = jax.random.split(key, 24)
    D, HK = D_MODEL, HG_HEADS * HG_DIM
    nrm = jax.random.normal
    s = D ** -0.5
    return {
        "x": nrm(ks[0], (BATCH, SEQ, D), jnp.float32),
        "c": nrm(ks[1], (BATCH, D), jnp.float32),
        "ctx": nrm(ks[2], (BATCH, CTX_LEN, D), jnp.float32),
        "c_ctx": nrm(ks[3], (D,), jnp.float32),
        "ada_w": nrm(ks[4], (DEPTH, D, 6 * D), jnp.float32) * (0.5 * s),
        "ada_b": nrm(ks[5], (DEPTH, 6 * D), jnp.float32) * 0.02,
        "norm_mix": 1.0 + 0.1 * nrm(ks[6], (DEPTH, D), jnp.float32),
        "norm_ffn": 1.0 + 0.1 * nrm(ks[7], (DEPTH, D), jnp.float32),
        "attn_w_qkv": nrm(ks[8], (N_ATTN_LAYERS, D, 3 * D), jnp.float32) * s,
        "attn_w_o": nrm(ks[9], (N_ATTN_LAYERS, DA_HEADS * DA_V_DIM, D), jnp.float32) * s,
        "attn_q_norm": 1.0 + 0.1 * nrm(ks[10], (N_ATTN_LAYERS, DA_QK_DIM), jnp.float32),
        "attn_k_norm": 1.0 + 0.1 * nrm(ks[11], (N_ATTN_LAYERS, DA_QK_DIM), jnp.float32),
        "attn_sub_norm": 1.0 + 0.1 * nrm(ks[12], (N_ATTN_LAYERS, DA_V_DIM), jnp.float32),
        "attn_lambda": 0.1 * nrm(ks[13], (N_ATTN_LAYERS, 4, DA_QK_DIM), jnp.float32),
        "hgrn_w_in": nrm(ks[14], (N_HGRN_LAYERS, D, 5 * HK), jnp.float32) * s,
        "hgrn_w_o": nrm(ks[15], (N_HGRN_LAYERS, HK, D), jnp.float32) * s,
        "hgrn_out_norm": 1.0 + 0.1 * nrm(ks[16], (N_HGRN_LAYERS, HG_DIM), jnp.float32),
        "hgrn_lb_gamma": nrm(ks[17], (2, DEPTH, HK), jnp.float32),
        "router_w": nrm(ks[18], (D, N_EXPERTS), jnp.float32) * s,
        "router_bias": 0.01 * nrm(ks[19], (N_EXPERTS,), jnp.float32),
        "moe_w_gate": nrm(ks[20], (DEPTH, N_EXPERTS, D, D_FF), jnp.float32) * s,
        "moe_w_up": nrm(ks[21], (DEPTH, N_EXPERTS, D, D_FF), jnp.float32) * s,
        "moe_w_down": nrm(ks[22], (DEPTH, N_EXPERTS, D_FF, D), jnp.float32) * (D_FF ** -0.5),
    }


def reference(x, c, ctx, c_ctx, ada_w, ada_b, norm_mix, norm_ffn, attn_w_qkv, attn_w_o,
              attn_q_norm, attn_k_norm, attn_sub_norm, attn_lambda, hgrn_w_in, hgrn_w_o,
              hgrn_out_norm, hgrn_lb_gamma, router_w, router_bias, moe_w_gate, moe_w_up,
              moe_w_down):
    B, T, D = x.shape
    P = jax.nn.softmax(hgrn_lb_gamma.astype(jnp.float32), axis=1)
    cum = jnp.cumsum(P, axis=1)
    lb_all = (cum - cum[:, :1]).reshape(2, DEPTH, HG_HEADS, HG_DIM)

    xc = ctx
    for i in range(DEPTH):
        need_ctx = i < DEPTH - 1
        mod = jax.nn.silu(c) @ ada_w[i] + ada_b[i]
        sh_m, sc_m, g_m, sh_f, sc_f, g_f = jnp.split(mod[:, None, :], 6, axis=-1)
        modc = jax.nn.silu(c_ctx) @ ada_w[i] + ada_b[i]
        shc_m, scc_m, gc_m, shc_f, scc_f, gc_f = jnp.split(modc, 6, axis=-1)

        h = rms_norm(x, norm_mix[i]) * (1.0 + sc_m) + sh_m
        hc = rms_norm(xc, norm_mix[i]) * (1.0 + scc_m) + shc_m
        j = i // N_MIXERS
        if i % N_MIXERS == 0:
            out, out_c = diff_attention_mixer(h, hc, attn_w_qkv[j], attn_w_o[j], attn_q_norm[j],
                                              attn_k_norm[j], attn_sub_norm[j], attn_lambda[j],
                                              i, need_ctx)
        else:
            out, out_c = hgrn2_mixer(h, hc, hgrn_w_in[j], hgrn_w_o[j], hgrn_out_norm[j],
                                     lb_all[:, i], need_ctx)
        x = x + g_m * out

        f = rms_norm(x, norm_ffn[i]) * (1.0 + sc_f) + sh_f
        if need_ctx:
            xc = xc + gc_m * out_c
            fc = rms_norm(xc, norm_ffn[i]) * (1.0 + scc_f) + shc_f
            tokens = jnp.concatenate([f.reshape(-1, D), fc.reshape(-1, D)], axis=0)
            y = moe_ffn(tokens, router_w, router_bias, moe_w_gate[i], moe_w_up[i], moe_w_down[i])
            x = x + g_f * y[:B * T].reshape(B, T, D)
            xc = xc + gc_f * y[B * T:].reshape(xc.shape)
        else:
            y = moe_ffn(f.reshape(-1, D), router_w, router_bias, moe_w_gate[i], moe_w_up[i],
                        moe_w_down[i])
            x = x + g_f * y.reshape(B, T, D)
    return x
```

```cpp
#include <hip/hip_runtime.h>
#include <cstdio>
#include <cstdint>

#ifndef MK_PER_PHASE
#define MK_PER_PHASE 0
#endif
#ifndef MK_STOP_AFTER
#define MK_STOP_AFTER 99
#endif

namespace pg8 {
#define PG8_LAS __attribute__((address_space(3)))
typedef unsigned short bf16_t;
typedef short bf16x8 __attribute__((ext_vector_type(8)));
typedef float f32x4 __attribute__((ext_vector_type(4)));
typedef unsigned u32x4 __attribute__((ext_vector_type(4)));
constexpr int BM = 256, BK = 64, HALF = 128, HTB = HALF * BK * 2  , STAGE_BYTES = 8 * HTB, NXCD = 8, WGM = 8;

__host__ __device__ __forceinline__ int lds_byte(int r, int c) { const int st = (r >> 4) * 2 + (c >> 5), rr = r & 15, cc = c & 31, ob = rr * 64 + cc * 2; return st * 1024 + (ob ^ (((ob >> 9) & 1) << 5)); }
__host__ __device__ __forceinline__ void stage_rc(int b, int& R, int& C) { const int st = b / 1024, sb = b % 1024, swz = sb ^ (((sb >> 9) & 1) << 5); R = (st >> 1) * 16 + swz / 64; C = (st & 1) * 32 + (swz % 64) / 2; }

struct Unit { int pm, pn, e, mt, cnt; };
struct Gemm { const bf16_t* A; const bf16_t* Bt; int K; const int* gidx; };

struct StaticOrder {
    int nM, nN, nwg, G, c;
    __host__ __device__ void init(int M, int N, int G_, int c_) { nM = M / BM; nN = N / BM; nwg = nM * nN; G = G_; c = c_; }
    __host__ __device__ bool next(int i, Unit& u) const {
        const long L = (long)i * G + c; if (L >= nwg) return false;
        int wgid = (int)L; { const int q = nwg / NXCD, r = nwg % NXCD, xcd = wgid % NXCD, off = wgid / NXCD; wgid = (xcd < r ? xcd * (q + 1) : r * (q + 1) + (xcd - r) * q) + off; }
        const int nig = WGM * nN, gid = wgid / nig, fm = gid * WGM, gsz = (nM - fm) < WGM ? (nM - fm) : WGM;
        u.pm = fm + ((wgid % nig) % gsz); u.pn = (wgid % nig) / gsz; u.e = 0; u.mt = 0; u.cnt = 0; return true;
    }
};
constexpr int LISTCAP = 18432;
template <bool GATHER> __device__ __forceinline__ void unit_voff(const Gemm& g, const Unit& u, int tid, unsigned (&v0)[2], unsigned (&v1)[2]) {
#pragma unroll
    for (int i = 0; i < 2; ++i) { int R, C; stage_rc(tid * 16 + i * 8192, R, C);
        if constexpr (GATHER) {
            const int p0 = u.mt * 256 + R, p1 = p0 + 128;
            const int e0 = p0 < u.cnt ? g.gidx[u.e * LISTCAP + p0] : 0, e1 = p1 < u.cnt ? g.gidx[u.e * LISTCAP + p1] : 0;
            v0[i] = (unsigned)((e0 >> 1) * g.K + C) * 2u; v1[i] = (unsigned)((e1 >> 1) * g.K + C) * 2u;
        } else { v0[i] = (unsigned)(R * g.K + C) * 2u; v1[i] = v0[i]; }
    }
}
template <class Epi, class Sched, bool GATHER>
__device__ __forceinline__ void gemm_phase(PG8_LAS unsigned char* lds, const Gemm g, const Sched& S, const Epi& E) {
    const int tid = threadIdx.x, wid = __builtin_amdgcn_readfirstlane(tid >> 6), lane = tid & 63, wr = wid >> 2, wc = wid & 3, fr = lane & 15, fq = lane >> 4;
    const int K = g.K, nt = K / BK;
    unsigned voffB[2];
#pragma unroll
    for (int i = 0; i < 2; ++i) { int R, C; stage_rc(tid * 16 + i * 8192, R, C); voffB[i] = (unsigned)(R * K + C) * 2u; }
    const size_t kstep = (size_t)(BK * 2);
    const size_t hstep = (size_t)HALF * K * 2;
    const size_t tstep = 2 * hstep;
    const size_t hstepA = GATHER ? 0 : hstep;
    const unsigned ldsw = (unsigned)wid * 1024u;
    const int aoff = lds_byte(wr * 64 + fr, fq * 8), boff = lds_byte(wc * 32 + fr, fq * 8);
#define PG8_SA(b, h) (((b) * 2 + (h)) * HTB)
#define PG8_SB(b, h) ((4 + (b) * 2 + (h)) * HTB)
#define PG8_STAGE(bufoff, gbase, voff) do { _Pragma("unroll") for (int _i = 0; _i < 2; ++_i) \
        __builtin_amdgcn_global_load_lds((const unsigned*)((const char*)(gbase) + (voff)[_i]), (PG8_LAS unsigned*)(lds + (bufoff) + ldsw + _i * 8192), 16, 0, 0); } while (0)
#define PG8_LDA(dst, b, h) do { _Pragma("unroll") for (int m = 0; m < 4; ++m) _Pragma("unroll") for (int k = 0; k < 2; ++k) dst[m][k] = *(const PG8_LAS bf16x8*)(lds + PG8_SA(b, h) + aoff + m * 2048 + k * 1024); } while (0)
#define PG8_LDB(dst, b, h) do { _Pragma("unroll") for (int n = 0; n < 2; ++n) _Pragma("unroll") for (int k = 0; k < 2; ++k) dst[n][k] = *(const PG8_LAS bf16x8*)(lds + PG8_SB(b, h) + boff + n * 2048 + k * 1024); } while (0)
#define PG8_MMA(ai, bj, At, Bt) do { __builtin_amdgcn_s_setprio(1); _Pragma("unroll") for (int m = 0; m < 4; ++m) _Pragma("unroll") for (int n = 0; n < 2; ++n) _Pragma("unroll") for (int k = 0; k < 2; ++k) \
        acc[ai][bj][m][n] = __builtin_amdgcn_mfma_f32_16x16x32_bf16(Bt[n][k], At[m][k], acc[ai][bj][m][n], 0, 0, 0); __builtin_amdgcn_s_setprio(0); } while (0)
#define PG8_WAIT_V(n) asm volatile("s_waitcnt vmcnt(" #n ")" ::: "memory")
#define PG8_WAIT_L(n) asm volatile("s_waitcnt lgkmcnt(" #n ")" ::: "memory")
#define PG8_BAR __builtin_amdgcn_s_barrier()
#define PG8_SCHED __builtin_amdgcn_sched_barrier(0)
    Unit cur, nxt; int ui = 0;
    if (!S.next(0, cur)) return;
    f32x4 acc[2][2][4][2];
#pragma unroll
    for (int a = 0; a < 2; ++a)
#pragma unroll
        for (int b = 0; b < 2; ++b)
#pragma unroll
            for (int m = 0; m < 4; ++m)
#pragma unroll
                for (int n = 0; n < 2; ++n) acc[a][b][m][n] = (f32x4){0.f, 0.f, 0.f, 0.f};
    bf16x8 At[4][2], B0[2][2], B1[2][2];
    unsigned cv0[2], cv1[2], nv0[2], nv1[2];
    unit_voff<GATHER>(g, cur, tid, cv0, cv1);
    const char* cA = (const char*)g.A + (GATHER ? (size_t)0 : (size_t)cur.pm * tstep); const char* cB = (const char*)g.Bt + (size_t)cur.pn * tstep;
    PG8_STAGE(PG8_SB(0, 0), cB, voffB); PG8_STAGE(PG8_SB(0, 1), cB + hstep, voffB); PG8_STAGE(PG8_SA(0, 0), cA, cv0); PG8_STAGE(PG8_SA(0, 1), cA + hstepA, cv1);
    if (wr == 1) PG8_BAR;
    PG8_WAIT_V(2); PG8_BAR;
    PG8_STAGE(PG8_SB(1, 0), cB + kstep, voffB); PG8_STAGE(PG8_SA(1, 0), cA + kstep, cv0); PG8_STAGE(PG8_SB(1, 1), cB + hstep + kstep, voffB);
    PG8_WAIT_V(6); PG8_BAR;
    for (;;) {
        const bool has_next = S.next(ui + 1, nxt);
        const char* nA = has_next ? (const char*)g.A + (GATHER ? (size_t)0 : (size_t)nxt.pm * tstep) : cA; const char* nB = has_next ? (const char*)g.Bt + (size_t)nxt.pn * tstep : cB;
        if (has_next) unit_voff<GATHER>(g, nxt, tid, nv0, nv1); else { nv0[0] = cv0[0]; nv0[1] = cv0[1]; nv1[0] = cv1[0]; nv1[1] = cv1[1]; }
        for (int t = 0; t < nt; t += 2) {
            const bool last = (t == nt - 2);
            const char* a1 = cA + (size_t)(t + 1) * kstep;
            const char* a2 = last ? nA : cA + (size_t)(t + 2) * kstep; const char* b2 = last ? nB : cB + (size_t)(t + 2) * kstep;
            const char* a3 = a2 + kstep; const char* b3 = b2 + kstep;
            unsigned w0[2], w1[2];
            if constexpr (GATHER) { w0[0] = last ? nv0[0] : cv0[0]; w0[1] = last ? nv0[1] : cv0[1]; w1[0] = last ? nv1[0] : cv1[0]; w1[1] = last ? nv1[1] : cv1[1]; }
            else { w0[0] = cv0[0]; w0[1] = cv0[1]; w1[0] = cv0[0]; w1[1] = cv0[1]; }
            PG8_LDB(B0, 0, 0); PG8_LDB(B1, 0, 1); PG8_SCHED; PG8_LDA(At, 0, 0); PG8_STAGE(PG8_SA(1, 1), a1 + hstepA, cv1);
            PG8_WAIT_V(8); PG8_WAIT_L(0); PG8_BAR; PG8_MMA(0, 0, At, B0); PG8_MMA(0, 1, At, B1); PG8_BAR; PG8_SCHED;
            PG8_LDA(At, 0, 1); PG8_STAGE(PG8_SB(0, 0), b2, voffB); PG8_STAGE(PG8_SB(0, 1), b2 + hstep, voffB); PG8_STAGE(PG8_SA(0, 0), a2, w0);
            PG8_WAIT_V(8); PG8_WAIT_L(0); PG8_BAR; PG8_MMA(1, 0, At, B0); PG8_MMA(1, 1, At, B1); PG8_BAR; PG8_SCHED;
            PG8_LDB(B0, 1, 0); PG8_LDB(B1, 1, 1); PG8_SCHED; PG8_LDA(At, 1, 0); PG8_STAGE(PG8_SA(0, 1), a2 + hstepA, w1);
            PG8_WAIT_V(8); PG8_WAIT_L(0); PG8_BAR; PG8_MMA(0, 0, At, B0); PG8_MMA(0, 1, At, B1); PG8_BAR; PG8_SCHED;
            PG8_LDA(At, 1, 1); PG8_STAGE(PG8_SB(1, 0), b3, voffB); PG8_STAGE(PG8_SB(1, 1), b3 + hstep, voffB); PG8_STAGE(PG8_SA(1, 0), a3, w0);
            PG8_WAIT_V(8); PG8_WAIT_L(0); PG8_BAR; PG8_MMA(1, 0, At, B0); PG8_MMA(1, 1, At, B1); PG8_BAR; PG8_SCHED;
        }
        if (wr == 0) PG8_BAR;
        E(acc, cur, wr, wc, fr, fq);
        if (!has_next) break;
#pragma unroll
        for (int a = 0; a < 2; ++a)
#pragma unroll
            for (int b = 0; b < 2; ++b)
#pragma unroll
                for (int m = 0; m < 4; ++m)
#pragma unroll
                    for (int n = 0; n < 2; ++n) acc[a][b][m][n] = (f32x4){0.f, 0.f, 0.f, 0.f};
        cur = nxt; cA = nA; cB = nB; ++ui;
        cv0[0] = nv0[0]; cv0[1] = nv0[1]; cv1[0] = nv1[0]; cv1[1] = nv1[1];
        if (wr == 1) PG8_BAR;
    }
    PG8_WAIT_V(0);
    PG8_BAR;
#undef PG8_SA
#undef PG8_SB
#undef PG8_STAGE
#undef PG8_LDA
#undef PG8_LDB
#undef PG8_MMA
#undef PG8_WAIT_V
#undef PG8_WAIT_L
#undef PG8_BAR
#undef PG8_SCHED
}
}
#define GAS __attribute__((address_space(1)))
#define LAS __attribute__((address_space(3)))
typedef unsigned short bf16;
typedef unsigned v4u __attribute__((ext_vector_type(4)));
typedef float f32x4 __attribute__((ext_vector_type(4)));
typedef short bf16x8 __attribute__((ext_vector_type(8)));
typedef GAS unsigned gu32;
typedef GAS unsigned long long gu64;
#define RLX_AGENT __ATOMIC_RELAXED, __HIP_MEMORY_SCOPE_AGENT
#define LDS_WAIT() asm volatile("s_waitcnt lgkmcnt(0)" ::: "memory")
#define VM_WAIT() asm volatile("s_waitcnt vmcnt(0)" ::: "memory")
__device__ __forceinline__ unsigned long long rt() { return __builtin_amdgcn_s_memrealtime(); }
__device__ __forceinline__ unsigned f2bf(float f) { unsigned u = __builtin_bit_cast(unsigned, f); return (u + 0x7fffu + ((u >> 16) & 1u)) >> 16; }
__device__ __forceinline__ unsigned pk2(float lo, float hi) { return f2bf(lo) | (f2bf(hi) << 16); }

#define XB_TMO      128
#define XB_XCNT(j)  (256  + 64 * (j))
#define XB_XSUB(j)  (1280 + 64 * (j))
#define XB_XGEN(j)  (2304 + 64 * (j))
#define XB_TOP      3328
#define XB_TOPGEN   3392
#define XCD_BAR_WORDS 3456
#define XB_SPIN_CAP (1u << 18)

__device__ __forceinline__ unsigned xb_ld(unsigned* p)              { return __hip_atomic_load(p, __ATOMIC_RELAXED, __HIP_MEMORY_SCOPE_AGENT); }
__device__ __forceinline__ unsigned xb_add(unsigned* p, unsigned v) { return __hip_atomic_fetch_add(p, v, __ATOMIC_RELAXED, __HIP_MEMORY_SCOPE_AGENT); }
__device__ __forceinline__ unsigned xb_xcc_id() { return (unsigned)__builtin_amdgcn_s_getreg((3 << 11) | 20) & 0xFu; }
#define XB_SPIN(cond, bar) do { unsigned _sp = 0; while (cond) { __builtin_amdgcn_s_sleep(1); \
    if ((++_sp & 255u) == 0u) { if (xb_ld(&(bar)[XB_TMO])) break; if (_sp > XB_SPIN_CAP) { atomicAdd(&(bar)[XB_TMO], 1u); break; } } } } while (0)

struct XcdBarrier {
    unsigned* bar; unsigned x;
    volatile LAS unsigned* st;
};

__device__ __forceinline__ XcdBarrier xcd_barrier_post(unsigned* bar, volatile LAS unsigned* st) {
    XcdBarrier b; b.bar = bar; b.x = xb_xcc_id(); b.st = st;
    if (threadIdx.x == 0) (void)xb_add(&bar[XB_XCNT(b.x)], 1u);
    return b;
}
__device__ __forceinline__ void xcd_barrier_complete(unsigned* bar, unsigned x, unsigned& nloc, unsigned& nx) {
    const unsigned G = gridDim.x * gridDim.y * gridDim.z;
    unsigned sum, cnt, mine, sp = 0u;
    for (;;) {
        sum = 0u; cnt = 0u; mine = 0u;
#pragma unroll
        for (unsigned j = 0; j < 16; ++j) { const unsigned c = xb_ld(&bar[XB_XCNT(j)]); sum += c; cnt += (c > 0u) ? 1u : 0u; mine = (j == x) ? c : mine; }
        if (sum == G) break;
        __builtin_amdgcn_s_sleep(1);
        if ((++sp & 255u) == 0u) { if (xb_ld(&bar[XB_TMO])) break; if (sp > XB_SPIN_CAP) { atomicAdd(&bar[XB_TMO], 1u); break; } }
    }
    nloc = mine > 0u ? mine : 1u; nx = cnt > 0u ? cnt : 1u;
}

__device__ __forceinline__ void xcd_barrier(const XcdBarrier& b) {
    asm volatile("s_waitcnt vmcnt(0)" ::: "memory");
    __syncthreads();
    if (threadIdx.x == 0) {
        unsigned* bar = b.bar;
        __builtin_amdgcn_s_waitcnt(0);
        unsigned nloc = b.st[0], nx = b.st[1];
        if (nloc == 0u) { xcd_barrier_complete(bar, b.x, nloc, nx); b.st[0] = nloc; b.st[1] = nx; }
        const unsigned old = xb_add(&bar[XB_XSUB(b.x)], 1u);
        const unsigned gen = old / nloc;
        if (old + 1u == (gen + 1u) * nloc) {
            __builtin_amdgcn_fence(__ATOMIC_RELEASE, "agent");
            asm volatile("s_waitcnt vmcnt(0)" ::: "memory");
            const unsigned og = xb_add(&bar[XB_TOP], 1u);
            const unsigned tg = og / nx;
            if (og + 1u == (tg + 1u) * nx) xb_add(&bar[XB_TOPGEN], 1u);
            else XB_SPIN(xb_ld(&bar[XB_TOPGEN]) == tg, bar);
            __builtin_amdgcn_fence(__ATOMIC_ACQUIRE, "agent");
            xb_add(&bar[XB_XGEN(b.x)], 1u);
            asm volatile("s_waitcnt vmcnt(0)" ::: "memory");
        } else {
            XB_SPIN(xb_ld(&bar[XB_XGEN(b.x)]) == gen, bar);
            __builtin_amdgcn_fence(__ATOMIC_ACQUIRE, "agent");
            asm volatile("s_waitcnt vmcnt(0)" ::: "memory");
        }
    }
    __syncthreads();
}

typedef unsigned v2u __attribute__((ext_vector_type(2)));
typedef float f32x16 __attribute__((ext_vector_type(16)));
typedef short s16x4 __attribute__((ext_vector_type(4)));
constexpr int NWAVES = 8;
constexpr int D = 1024, NB = 8, TL = 2048, TCX = 256;
constexpr int NLAT = NB * TL, NCTX = NB * TCX, NR = NLAT + NCTX;
constexpr int SK = TL + TCX;
constexpr float EPS = 1e-6f;
constexpr float C2 = 0.125f * 1.4426950408889634f;
constexpr float LAM_INIT = 0.2f;
constexpr int NEXP = 16, DFF = 512;
constexpr int HIDROWS = 40960;

constexpr size_t MiB = 1u << 20;
constexpr size_t WS_CTL = 0, CTL_ZERO_BYTES = 1 * MiB;
constexpr size_t WS_MOD = 1 * MiB;
constexpr size_t WS_ROPE = 1 * MiB + 512 * 1024;
constexpr size_t WS_LB = 2 * MiB;
constexpr size_t WS_WGT = 2 * MiB + 64 * 1024;
constexpr size_t WS_LIST = 2 * MiB + 512 * 1024;
constexpr size_t WS_WQKV = 4 * MiB, WS_WO = 10 * MiB, WS_WIN = 12 * MiB, WS_WO2 = 22 * MiB, WS_WGU = 24 * MiB, WS_WD = 56 * MiB;
constexpr size_t WS_XC = 72 * MiB;
constexpr size_t WS_H = 80 * MiB;
constexpr size_t WS_OB = 116 * MiB;
constexpr size_t WS_R1 = 148 * MiB;
constexpr size_t WS_Q = WS_R1, WS_K = WS_R1 + 36 * MiB, WS_VT = WS_R1 + 72 * MiB;
constexpr size_t WS_HID = WS_R1, WS_YC = WS_R1 + 40 * MiB;
constexpr size_t WS_QH = WS_R1, WS_VH = WS_R1 + 36 * MiB, WS_ZF = WS_R1 + 72 * MiB, WS_ZB = WS_R1 + 108 * MiB, WS_GH = WS_R1 + 144 * MiB;
constexpr size_t WS_END = WS_R1 + 180 * MiB;
static_assert(WS_YC + (size_t)2 * NR * D * 2 <= WS_END && WS_HID + (size_t)HIDROWS * DFF * 2 <= WS_YC, "ws map");
constexpr int CW_BAR = 4096;
constexpr int CW_CNT = 16384;

constexpr int RING_OFF = 0, RING_BYTES = 131072;
constexpr int LDSCTL_OFF = RING_BYTES, MISC_OFF = LDSCTL_OFF + 320;
constexpr int LDS_BYTES = 147456;
static_assert(MISC_OFF + 256 <= LDS_BYTES, "LDS map");

struct Frame {
    LAS unsigned char* lds;
    volatile LAS unsigned* MISC;
    gu32* ctl;
    int tid, lane, wave;
    int vcu, G;
    unsigned char* ws;
    const float* in[23];
    float* out;
};
enum { I_X = 0, I_C, I_CTX, I_CCTX, I_ADAW, I_ADAB, I_NMIX, I_NFFN, I_WQKV, I_WO, I_QN, I_KN, I_SUBN, I_LAM, I_WIN, I_WO2, I_ONORM, I_LBG, I_RW, I_RB, I_MG, I_MU, I_MD };

__device__ __forceinline__ float bf2f(unsigned short u) { return __uint_as_float((unsigned)u << 16); }
__device__ __forceinline__ float bflo(unsigned u) { return __uint_as_float(u << 16); }
__device__ __forceinline__ float bfhi(unsigned u) { return __uint_as_float(u & 0xffff0000u); }
__device__ __forceinline__ float wave_sum(float v) {
#pragma unroll
    for (int o = 1; o < 64; o <<= 1) v += __shfl_xor(v, o);
    return v;
}
__device__ __forceinline__ float siluf(float x) { return x / (1.f + __expf(-x)); }
__device__ __forceinline__ float sigmf(float x) { return 1.f / (1.f + __expf(-x)); }
__device__ __forceinline__ int row_batch(int r) { return r < NLAT ? (r >> 11) : ((r - NLAT) >> 8); }
__device__ __forceinline__ int row_modidx(int r) { return r < NLAT ? (r >> 11) : 8; }

__device__ __forceinline__ void p0_transpose_item(const float* W, int K, int N, bf16* WT, int k0, int n0, int drow0, LAS float* scr, int lane) {
#pragma unroll 8
    for (int i = 0; i < 32; ++i) { const int kk = 2 * i + (lane >> 5); scr[kk * 33 + (lane & 31)] = W[(size_t)(k0 + kk) * N + n0 + (lane & 31)]; }
    LDS_WAIT(); asm volatile("" ::: "memory");
    const int c = lane & 7;
#pragma unroll
    for (int j = 0; j < 4; ++j) { const int n = (lane >> 3) + 8 * j; const LAS float* s = scr + (8 * c) * 33 + n;
        v4u o; o.x = pk2(s[0 * 33], s[1 * 33]); o.y = pk2(s[2 * 33], s[3 * 33]); o.z = pk2(s[4 * 33], s[5 * 33]); o.w = pk2(s[6 * 33], s[7 * 33]);
        *(GAS v4u*)(WT + (size_t)(drow0 + n) * K + k0 + 8 * c) = o; }
    LDS_WAIT(); asm volatile("" ::: "memory");
}
__device__ __forceinline__ void p0_transpose_mat(Frame& F, const float* W, int K, int N, bf16* WT, int kind, int item, LAS float* scr) {
    const int nblk = N / 32, kb = item / nblk, nb = item % nblk, n0 = 32 * nb;
    int drow0 = n0;
    if (kind == 1) { const int lt = n0 & 255, wcg = lt >> 6, bj = (lt >> 5) & 1; drow0 = (n0 & ~255) + 128 * bj + 32 * wcg; }
    p0_transpose_item(W, K, N, WT, 64 * kb, n0, drow0, scr, F.lane);
}
constexpr int MOE_ITEMS_GU = 16 * 16 * 16, MOE_ITEMS_D = 16 * 8 * 32, MOE_ITEMS = 2 * MOE_ITEMS_GU + MOE_ITEMS_D;
__device__ __forceinline__ void p0_moe_item(Frame& F, int layer, int it, LAS float* scr) {
    bf16* Wgu = (bf16*)(F.ws + WS_WGU); bf16* Wd = (bf16*)(F.ws + WS_WD);
    if (it < 2 * MOE_ITEMS_GU) {
        const int isup = it >= MOE_ITEMS_GU; if (isup) it -= MOE_ITEMS_GU;
        const int e = it >> 8, r = it & 255, kb = r >> 4, nb = r & 15, n0 = 32 * nb;
        const float* W = (isup ? F.in[I_MU] : F.in[I_MG]) + ((size_t)layer * NEXP + e) * (size_t)(D * DFF);
        const int drow0 = (n0 >> 7) * 256 + (isup ? 128 : 0) + (n0 & 127);
        p0_transpose_item(W, D, DFF, Wgu + (size_t)e * D * D, 64 * kb, n0, drow0, scr, F.lane);
    } else {
        it -= 2 * MOE_ITEMS_GU;
        const int e = it >> 8, r = it & 255, kb = r >> 5, nb = r & 31, n0 = 32 * nb;
        const float* W = F.in[I_MD] + ((size_t)layer * NEXP + e) * (size_t)(DFF * D);
        p0_transpose_item(W, DFF, D, Wd + (size_t)e * D * DFF, 64 * kb, n0, n0, scr, F.lane);
    }
}

__device__ __forceinline__ void p0_prep(Frame& F) {
    const int tid = F.tid, lane = F.lane, wave = F.wave;
    {
        LAS float* sc = (LAS float*)(F.lds);
        LAS float* part = (LAS float*)(F.lds + 40960);
        if ((int)blockIdx.x < 192) {
            for (int i = tid; i < 9 * 1024; i += 512) { const int b = i >> 10, k = i & 1023; const float v = b < 8 ? F.in[I_C][b * 1024 + k] : F.in[I_CCTX][k]; sc[i] = siluf(v); }
            __syncthreads();
            for (int it = blockIdx.x; it < 192; it += F.G) {
                const int layer = it / 96, cg = it % 96, col = cg * 64 + lane;
                const float* W = F.in[I_ADAW] + (size_t)layer * D * 6144 + col;
                float a[9];
#pragma unroll
                for (int b = 0; b < 9; ++b) a[b] = 0.f;
                for (int k = wave * 128; k < wave * 128 + 128; ++k) { const float w = W[(size_t)k * 6144];
#pragma unroll
                    for (int b = 0; b < 9; ++b) a[b] += sc[b * 1024 + k] * w; }
#pragma unroll
                for (int b = 0; b < 9; ++b) part[(wave * 9 + b) * 64 + lane] = a[b];
                __syncthreads();
                for (int i = tid; i < 9 * 64; i += 512) { const int b = i >> 6, c = i & 63; float s = 0.f;
#pragma unroll
                    for (int w = 0; w < 8; ++w) s += part[(w * 9 + b) * 64 + c];
                    ((float*)(F.ws + WS_MOD))[((size_t)layer * 9 + b) * 6144 + cg * 64 + c] = s + F.in[I_ADAB][layer * 6144 + cg * 64 + c]; }
                __syncthreads();
            }
        }
        __syncthreads();
    }
    {
        LAS float* scr = (LAS float*)(F.lds + RING_OFF + wave * 16384);
        const int gw = F.vcu * NWAVES + wave, NGW = F.G * NWAVES;
        constexpr int I_A = 16 * 96, I_B = 16 * 32, I_C2 = 16 * 160, I_D = 16 * 32;
        constexpr int NIT = I_A + I_B + I_C2 + I_D + MOE_ITEMS;
        for (int it = gw; it < NIT; it += NGW) {
            int r = it;
            if (r < I_A) { p0_transpose_mat(F, F.in[I_WQKV], D, 3072, (bf16*)(F.ws + WS_WQKV), 1, r, scr); continue; } r -= I_A;
            if (r < I_B) { p0_transpose_mat(F, F.in[I_WO], D, D, (bf16*)(F.ws + WS_WO), 0, r, scr); continue; } r -= I_B;
            if (r < I_C2) { p0_transpose_mat(F, F.in[I_WIN], D, 5120, (bf16*)(F.ws + WS_WIN), 0, r, scr); continue; } r -= I_C2;
            if (r < I_D) { p0_transpose_mat(F, F.in[I_WO2], D, D, (bf16*)(F.ws + WS_WO2), 0, r, scr); continue; } r -= I_D;
            p0_moe_item(F, 0, r, scr);
        }
    }
    {
        const int gt = blockIdx.x * 512 + tid, NGT = F.G * 512;
        float* cosT = (float*)(F.ws + WS_ROPE); float* sinT = cosT + 2048 * 32;
        for (int i = gt; i < 2048 * 32; i += NGT) { const int t = i >> 5, j = i & 31; const float pos = (j < 16) ? (float)(t >> 6) : (float)(t & 63);
            const float inv = powf(10000.0f, -(float)(j & 15) / 16.0f); const float ang = pos * inv; cosT[i] = cosf(ang); sinT[i] = sinf(ang); }
        float* lb = (float*)(F.ws + WS_LB);
        for (int i = gt; i < 2048; i += NGT) { const int dir = i >> 10, hk = i & 1023; const float g0 = F.in[I_LBG][(dir * 2 + 0) * 1024 + hk], g1 = F.in[I_LBG][(dir * 2 + 1) * 1024 + hk];
            lb[i] = 1.f / (1.f + expf(g0 - g1)); }
        if (gt == 0) {
            const float* lp = F.in[I_LAM]; float s0 = 0.f, s1 = 0.f;
            for (int i = 0; i < 64; ++i) { s0 += lp[i] * lp[64 + i]; s1 += lp[128 + i] * lp[192 + i]; }
            float mq = 0.f, mk = 0.f; for (int i = 0; i < 64; ++i) { mq = fmaxf(mq, fabsf(F.in[I_QN][i])); mk = fmaxf(mk, fabsf(F.in[I_KN][i])); }
            float* sc = (float*)(F.ws + WS_LB + 8192);
            sc[0] = expf(s0) - expf(s1) + LAM_INIT;
            sc[1] = 8.0f * mq * mk * 1.4426950408889634f;
        }
    }
}

__device__ __forceinline__ void row_norm_store(const f32x4 (&v)[4], const float* gamma, const float* sh, const float* sc, bf16* orow, int lane, f32x4 (&f)[4]) {
    float ss = 0.f;
#pragma unroll
    for (int j = 0; j < 4; ++j) ss += (v[j].x * v[j].x + v[j].y * v[j].y) + (v[j].z * v[j].z + v[j].w * v[j].w);
    const float rstd = 1.0f / sqrtf(wave_sum(ss) * (1.f / D) + EPS);
    GAS unsigned long long* o8 = (GAS unsigned long long*)orow + lane;
#pragma unroll
    for (int j = 0; j < 4; ++j) { const int c = 4 * lane + 256 * j; const f32x4 g = *(const f32x4*)(gamma + c), s1 = *(const f32x4*)(sc + c), s0 = *(const f32x4*)(sh + c);
        f[j] = (v[j] * rstd) * g * (s1 + 1.0f) + s0;
        o8[64 * j] = (unsigned long long)pk2(f[j].x, f[j].y) | ((unsigned long long)pk2(f[j].z, f[j].w) << 32); }
}
__device__ __forceinline__ const float* row_src(Frame& F, int r, const float* xl, const float* xc) { return r < NLAT ? xl + (size_t)r * D : xc + (size_t)(r - NLAT) * D; }

__device__ __forceinline__ void p_norm_mix0(Frame& F) {
    const int gw = F.vcu * NWAVES + F.wave, NGW = F.G * NWAVES;
    const float* mod = (const float*)(F.ws + WS_MOD);
    for (int r = gw; r < NR; r += NGW) {
        const float* src = row_src(F, r, F.in[I_X], F.in[I_CTX]);
        f32x4 v[4], f[4];
#pragma unroll
        for (int j = 0; j < 4; ++j) v[j] = *(const f32x4*)(src + 4 * F.lane + 256 * j);
        const float* m = mod + (size_t)(0 * 9 + row_modidx(r)) * 6144;
        row_norm_store(v, F.in[I_NMIX], m, m + 1024, (bf16*)(F.ws + WS_H) + (size_t)r * D, F.lane, f);
    }
}

struct EpiQKV {
    bf16* Q; bf16* K; bf16* Vt; const float* qn; const float* kn; const float* cosT; const float* sinT;
    __device__ __forceinline__ void operator()(const f32x4 (&acc)[2][2][4][2], const pg8::Unit& u, int wr, int wc, int fr, int fq) const {
        const int sec = u.pn >> 2, ts = u.pn & 3, h = 2 * ts + (wc >> 1), mp = wc & 1;
        const bool lat = u.pm < 64;
        const int b = lat ? (u.pm >> 3) : (u.pm - 64);
        const int s0 = lat ? ((u.pm & 7) << 8) : TL;
        if (sec < 2) {
            const float* wn = sec == 0 ? qn : kn;
            f32x4 w[2][2];
#pragma unroll
            for (int bj = 0; bj < 2; ++bj)
#pragma unroll
                for (int n = 0; n < 2; ++n) w[bj][n] = *(const f32x4*)(wn + 32 * bj + 16 * n + 4 * fq);
#pragma unroll
            for (int ai = 0; ai < 2; ++ai)
#pragma unroll
                for (int m = 0; m < 4; ++m) {
                    const int rloc = ai * 128 + wr * 64 + m * 16 + fr, r = u.pm * 256 + rloc;
                    float ss = 0.f;
#pragma unroll
                    for (int bj = 0; bj < 2; ++bj)
#pragma unroll
                        for (int n = 0; n < 2; ++n) { const f32x4 x = acc[ai][bj][m][n]; ss += (x.x * x.x + x.y * x.y) + (x.z * x.z + x.w * x.w); }
                    ss += __shfl_xor(ss, 16); ss += __shfl_xor(ss, 32);
                    const float rstd = 1.0f / sqrtf(ss * (1.f / 64.f) + EPS);
                    f32x4 y[2][2];
#pragma unroll
                    for (int bj = 0; bj < 2; ++bj)
#pragma unroll
                        for (int n = 0; n < 2; ++n) y[bj][n] = acc[ai][bj][m][n] * rstd * w[bj][n];
                    if (lat) { const int t = r & (TL - 1);
#pragma unroll
                        for (int n = 0; n < 2; ++n) { const f32x4 cs = *(const f32x4*)(cosT + t * 32 + 16 * n + 4 * fq), sn = *(const f32x4*)(sinT + t * 32 + 16 * n + 4 * fq);
                            const f32x4 x1 = y[0][n], x2 = y[1][n]; y[0][n] = x1 * cs - x2 * sn; y[1][n] = x2 * cs + x1 * sn; } }
                    bf16* dst = sec == 0 ? Q + (size_t)r * D + h * 128 + mp * 64 : K + ((size_t)b * SK + s0 + rloc) * D + h * 128 + mp * 64;
                    const float sc = sec == 0 ? C2 : 1.0f;
#pragma unroll
                    for (int bj = 0; bj < 2; ++bj)
#pragma unroll
                        for (int n = 0; n < 2; ++n) { const f32x4 o = y[bj][n] * sc; v2u pk; pk.x = pk2(o.x, o.y); pk.y = pk2(o.z, o.w); *(v2u*)(dst + 32 * bj + 16 * n + 4 * fq) = pk; }
                }
        } else {
            bf16* vb = Vt + ((size_t)(b * 8 + h) * 128 + mp * 64) * SK + s0;
#pragma unroll
            for (int ai = 0; ai < 2; ++ai)
#pragma unroll
                for (int m = 0; m < 4; ++m) { const int rloc = ai * 128 + wr * 64 + m * 16 + fr;
#pragma unroll
                    for (int bj = 0; bj < 2; ++bj)
#pragma unroll
                        for (int n = 0; n < 2; ++n) { const f32x4 x = acc[ai][bj][m][n]; bf16* p = vb + (size_t)(32 * bj + 16 * n + 4 * fq) * SK + rloc;
                            p[0] = (bf16)f2bf(x.x); p[SK] = (bf16)f2bf(x.y); p[2 * SK] = (bf16)f2bf(x.z); p[3 * SK] = (bf16)f2bf(x.w); } }
        }
    }
};

constexpr int ATT_K1 = 8192, ATT_VT = 16384, ATT_STAGE = 32768;
static_assert(2 * ATT_STAGE <= RING_BYTES, "attention LDS");
__device__ __forceinline__ unsigned cvtpk(float lo, float hi) { return pk2(lo, hi); }
__device__ __forceinline__ void attn_unit(Frame& F, int b, int h, int qrow0, int kt0, int nkt, const float lam) {
    const int lane = F.lane, wid = F.wave, r32 = lane & 31, hi = lane >> 5;
    const bf16* Qg = (const bf16*)(F.ws + WS_Q); const bf16* Kg = (const bf16*)(F.ws + WS_K); const bf16* Vg = (const bf16*)(F.ws + WS_VT);
    bf16* Og = (bf16*)(F.ws + WS_Q);
    const int r = qrow0 + wid * 32 + r32;
    bf16x8 qf[2][4];
#pragma unroll
    for (int mp = 0; mp < 2; ++mp)
#pragma unroll
        for (int ks = 0; ks < 4; ++ks) qf[mp][ks] = *(const bf16x8*)(Qg + (size_t)r * D + h * 128 + mp * 64 + ks * 16 + hi * 8);
    f32x16 o[2][4];
#pragma unroll
    for (int mp = 0; mp < 2; ++mp)
#pragma unroll
        for (int bl = 0; bl < 4; ++bl)
#pragma unroll
            for (int i = 0; i < 16; ++i) o[mp][bl][i] = 0.f;
    float l0 = 0.f, l1 = 0.f;
    const int sb_ = lane >> 3, sc_ = (lane & 7) ^ sb_ ^ (wid & 3);
    const bf16* ksrc = Kg + ((size_t)b * SK + 8 * wid + sb_) * D + h * 128 + sc_ * 8;
    const bf16* vsrc = Vg + ((size_t)(b * 8 + h) * 128 + 8 * wid + sb_) * SK + sc_ * 8;
    LAS unsigned char* lds = F.lds;
    const unsigned dbase = (unsigned)wid * 1024u;
#define ATT_DMA(kt, st) do { \
        __builtin_amdgcn_global_load_lds((const unsigned*)(ksrc + (size_t)(kt) * 64 * D), (LAS unsigned*)(lds + (st) * ATT_STAGE + dbase), 16, 0, 0); \
        __builtin_amdgcn_global_load_lds((const unsigned*)(ksrc + (size_t)(kt) * 64 * D + 64), (LAS unsigned*)(lds + (st) * ATT_STAGE + ATT_K1 + dbase), 16, 0, 0); \
        __builtin_amdgcn_global_load_lds((const unsigned*)(vsrc + (size_t)(kt) * 64), (LAS unsigned*)(lds + (st) * ATT_STAGE + ATT_VT + dbase), 16, 0, 0); \
        __builtin_amdgcn_global_load_lds((const unsigned*)(vsrc + (size_t)(kt) * 64 + (size_t)64 * SK), (LAS unsigned*)(lds + (st) * ATT_STAGE + ATT_VT + 8192 + dbase), 16, 0, 0); } while (0)
    const int sw = (r32 & 7) ^ ((r32 >> 3) & 3);
    ATT_DMA(kt0, 0);
    asm volatile("s_waitcnt vmcnt(0)" ::: "memory");
    __syncthreads();
    for (int t = 0; t < nkt; ++t) {
        const int st = t & 1;
        if (t + 1 < nkt) ATT_DMA(kt0 + t + 1, st ^ 1);
        const LAS unsigned char* kb = lds + st * ATT_STAGE;
#pragma unroll 1
        for (int sub = 0; sub < 2; ++sub) {
            unsigned pk[2][8];
#pragma unroll
            for (int mp = 0; mp < 2; ++mp) {
                f32x16 s = {0.f,0.f,0.f,0.f,0.f,0.f,0.f,0.f,0.f,0.f,0.f,0.f,0.f,0.f,0.f,0.f};
#pragma unroll
                for (int ks = 0; ks < 4; ++ks) { const bf16x8 kf = *(const LAS bf16x8*)(kb + mp * ATT_K1 + (sub * 32 + r32) * 128 + (((2 * ks + hi) ^ sw) << 4));
                    s = __builtin_amdgcn_mfma_f32_32x32x16_bf16(kf, qf[mp][ks], s, 0, 0, 0); }
                float ls = 0.f;
#pragma unroll
                for (int i = 0; i < 16; ++i) { s[i] = __builtin_amdgcn_exp2f(s[i]); ls += s[i]; }
                if (mp == 0) l0 += ls; else l1 += ls;
#pragma unroll
                for (int i = 0; i < 8; ++i) pk[mp][i] = cvtpk(s[2 * i], s[2 * i + 1]);
            }
#pragma unroll
            for (int bl = 0; bl < 4; ++bl)
#pragma unroll
                for (int ks = 0; ks < 2; ++ks) {
                    const LAS unsigned char* vrow = kb + ATT_VT + (bl * 32 + r32) * 128 + hi * 8;
                    const int c1 = 4 * sub + 2 * ks;
                    const v2u va = *(const LAS v2u*)(vrow + ((c1 ^ sw) << 4)), vb = *(const LAS v2u*)(vrow + (((c1 + 1) ^ sw) << 4));
                    v4u vv; vv.x = va.x; vv.y = va.y; vv.z = vb.x; vv.w = vb.y;
                    const bf16x8 vf = __builtin_bit_cast(bf16x8, vv);
                    v4u p0; p0.x = pk[0][4 * ks]; p0.y = pk[0][4 * ks + 1]; p0.z = pk[0][4 * ks + 2]; p0.w = pk[0][4 * ks + 3];
                    v4u p1; p1.x = pk[1][4 * ks]; p1.y = pk[1][4 * ks + 1]; p1.z = pk[1][4 * ks + 2]; p1.w = pk[1][4 * ks + 3];
                    o[0][bl] = __builtin_amdgcn_mfma_f32_32x32x16_bf16(vf, __builtin_bit_cast(bf16x8, p0), o[0][bl], 0, 0, 0);
                    o[1][bl] = __builtin_amdgcn_mfma_f32_32x32x16_bf16(vf, __builtin_bit_cast(bf16x8, p1), o[1][bl], 0, 0, 0);
                }
        }
        asm volatile("s_waitcnt vmcnt(0)" ::: "memory");
        __syncthreads();
    }
#undef ATT_DMA
    l0 += __shfl_xor(l0, 32); l1 += __shfl_xor(l1, 32);
    const float i0 = 1.0f / l0, i1 = lam / l1;
    float ss = 0.f;
#pragma unroll
    for (int bl = 0; bl < 4; ++bl)
#pragma unroll
        for (int i = 0; i < 16; ++i) { const float v = o[0][bl][i] * i0 - o[1][bl][i] * i1; o[0][bl][i] = v; ss += v * v; }
    ss += __shfl_xor(ss, 32);
    const float rstd = (1.0f - LAM_INIT) / sqrtf(ss * (1.f / 128.f) + EPS);
    const float* sn = F.in[I_SUBN];
    bf16* orow = Og + (size_t)r * D + h * 128;
#pragma unroll
    for (int bl = 0; bl < 4; ++bl)
#pragma unroll
        for (int g = 0; g < 4; ++g) { const int dv = bl * 32 + 8 * g + 4 * hi; const f32x4 w = *(const f32x4*)(sn + dv);
            v2u pkk; pkk.x = pk2(o[0][bl][4 * g] * rstd * w.x, o[0][bl][4 * g + 1] * rstd * w.y); pkk.y = pk2(o[0][bl][4 * g + 2] * rstd * w.z, o[0][bl][4 * g + 3] * rstd * w.w);
            *(v2u*)(orow + dv) = pkk; }
}
__device__ __forceinline__ void p_attention(Frame& F) {
    const float lam = ((const float*)(F.ws + WS_LB + 8192))[0];
    for (int u = F.vcu; u < 576; u += F.G) {
        if (u < 512) { const int bh = u >> 3, qb = u & 7, b = bh >> 3, h = bh & 7; attn_unit(F, b, h, b * TL + qb * 256, 0, SK / 64, lam); }
        else { const int bh = u - 512, b = bh >> 3, h = bh & 7; attn_unit(F, b, h, NLAT + b * TCX, TL / 64, TCX / 64, lam); }
    }
}

struct EpiResid {
    const float* src_l; float* dst_l; const float* src_c; float* dst_c; const float* modg;
    __device__ __forceinline__ void operator()(const f32x4 (&acc)[2][2][4][2], const pg8::Unit& u, int wr, int wc, int fr, int fq) const {
        const bool lat = u.pm < 64;
        const int mi = lat ? (u.pm >> 3) : 8;
        const float* src = lat ? src_l + (size_t)u.pm * 256 * D : src_c + (size_t)(u.pm - 64) * 256 * D;
        float* dst = lat ? dst_l + (size_t)u.pm * 256 * D : dst_c + (size_t)(u.pm - 64) * 256 * D;
        const int col0 = u.pn * 256 + wc * 32 + 4 * fq;
        f32x4 gv[2][2];
#pragma unroll
        for (int bj = 0; bj < 2; ++bj)
#pragma unroll
            for (int n = 0; n < 2; ++n) gv[bj][n] = *(const f32x4*)(modg + (size_t)mi * 6144 + col0 + bj * 128 + n * 16);
#pragma unroll
        for (int ai = 0; ai < 2; ++ai)
#pragma unroll
            for (int m = 0; m < 4; ++m) { const size_t off = (size_t)(ai * 128 + wr * 64 + m * 16 + fr) * D + col0;
#pragma unroll
                for (int bj = 0; bj < 2; ++bj)
#pragma unroll
                    for (int n = 0; n < 2; ++n) { const f32x4 xs = *(const f32x4*)(src + off + bj * 128 + n * 16); *(f32x4*)(dst + off + bj * 128 + n * 16) = xs + gv[bj][n] * acc[ai][bj][m][n]; } }
    }
};

__device__ __forceinline__ void p_ffn_router(Frame& F, int layer, int nrows) {
    const int tid = F.tid, lane = F.lane;
    LAS float* rwT = (LAS float*)(F.lds);
    for (int i = tid; i < 16 * 1024; i += 512) { const int k = i >> 4, e = i & 15; rwT[e * 1024 + k] = F.in[I_RW][i]; }
    __syncthreads();
    const int gw = F.vcu * NWAVES + F.wave, NGW = F.G * NWAVES;
    const float* mod = (const float*)(F.ws + WS_MOD) + (size_t)layer * 9 * 6144;
    const float* gam = F.in[I_NFFN] + layer * D;
    const float* xc = (const float*)(F.ws + WS_XC);
    gu32* cnt = F.ctl + CW_CNT + layer * 16 * 64;
    int* list = (int*)(F.ws + WS_LIST); float* wgt = (float*)(F.ws + WS_WGT);
    for (int r = gw; r < nrows; r += NGW) {
        const float* src = row_src(F, r, F.out, xc);
        f32x4 v[4], f[4];
#pragma unroll
        for (int j = 0; j < 4; ++j) v[j] = *(const f32x4*)(src + 4 * lane + 256 * j);
        const float* m = mod + (size_t)row_modidx(r) * 6144;
        row_norm_store(v, gam, m + 3072, m + 4096, (bf16*)(F.ws + WS_H) + (size_t)r * D, lane, f);
        float best = -1e30f; int bg = 0; float gb[4] = {0.f, 0.f, 0.f, 0.f}, ga[4] = {0.f, 0.f, 0.f, 0.f};
#pragma unroll 1
        for (int g = 0; g < 4; ++g) {
            float af4[4], bs4[4];
#pragma unroll
            for (int e4 = 0; e4 < 4; ++e4) { float p = 0.f; const int e = 4 * g + e4;
#pragma unroll
                for (int j = 0; j < 4; ++j) { const f32x4 w = *(const LAS f32x4*)(rwT + e * 1024 + 4 * lane + 256 * j); p += (f[j].x * w.x + f[j].y * w.y) + (f[j].z * w.z + f[j].w * w.w); }
                p = wave_sum(p); af4[e4] = 1.f / (1.f + expf(-p)); bs4[e4] = af4[e4] + F.in[I_RB][e]; }
            const float a = bs4[0], b2 = bs4[1], c = bs4[2], d = bs4[3];
            const float hi1 = fmaxf(a, b2), lo1 = fminf(a, b2), hi2 = fmaxf(c, d), lo2 = fminf(c, d);
            const float top = fmaxf(hi1, hi2), sec = fmaxf(fminf(hi1, hi2), fmaxf(lo1, lo2)); const float sc = top + sec;
            if (sc > best) { best = sc; bg = g;
#pragma unroll
                for (int j = 0; j < 4; ++j) { gb[j] = bs4[j]; ga[j] = af4[j]; } }
        }
        int i0 = 0; float b0 = gb[0];
#pragma unroll
        for (int j = 1; j < 4; ++j) if (gb[j] > b0) { b0 = gb[j]; i0 = j; }
        int i1 = -1; float b1 = -1e30f;
#pragma unroll
        for (int j = 0; j < 4; ++j) if (j != i0 && gb[j] > b1) { b1 = gb[j]; i1 = j; }
        const float a0 = i0 == 0 ? ga[0] : i0 == 1 ? ga[1] : i0 == 2 ? ga[2] : ga[3];
        const float a1 = i1 == 0 ? ga[0] : i1 == 1 ? ga[1] : i1 == 2 ? ga[2] : ga[3];
        const float inv = 1.0f / (a0 + a1);
        if (lane == 0) {
            const int e0 = bg * 4 + i0, e1 = bg * 4 + i1;
            const unsigned k0 = __hip_atomic_fetch_add(cnt + e0 * 64, 1u, RLX_AGENT), k1 = __hip_atomic_fetch_add(cnt + e1 * 64, 1u, RLX_AGENT);
            list[e0 * pg8::LISTCAP + (int)k0] = r * 2; list[e1 * pg8::LISTCAP + (int)k1] = r * 2 + 1;
            wgt[r * 2] = a0 * inv; wgt[r * 2 + 1] = a1 * inv;
        }
    }
    __syncthreads();
}

struct MoeOrder {
    volatile LAS int* tb;
    int G, c, NT;
    __device__ __forceinline__ void setup(Frame& F, int layer, int nt_) {
        tb = (volatile LAS int*)(F.MISC + 16); G = F.G; c = (int)blockIdx.x; NT = nt_;
        __syncthreads();
        if (F.tid == 0) { int acc = 0;
            for (int e = 0; e < 16; ++e) { const int n = (int)__hip_atomic_load(F.ctl + CW_CNT + (layer * 16 + e) * 64, RLX_AGENT); tb[e] = acc; tb[17 + e] = n; acc += (n + 255) >> 8; }
            tb[16] = acc; }
        __syncthreads();
    }
    __device__ __forceinline__ bool next(int i, pg8::Unit& u) const {
        const int L = i * G + c, tot = tb[16];
        if (L >= tot * NT) return false;
        const int T = L / NT, nt = L - T * NT;
        int e = 0;
#pragma unroll
        for (int k = 1; k < 16; ++k) e += (tb[k] <= T) ? 1 : 0;
        u.pm = T; u.pn = e * NT + nt; u.e = e; u.mt = T - tb[e]; u.cnt = tb[17 + e]; return true;
    }
};
struct EpiGateUp {
    bf16* hid;
    __device__ __forceinline__ void operator()(const f32x4 (&acc)[2][2][4][2], const pg8::Unit& u, int wr, int wc, int fr, int fq) const {
        const int hc0 = (u.pn & 3) * 128 + wc * 32 + 4 * fq;
#pragma unroll
        for (int ai = 0; ai < 2; ++ai)
#pragma unroll
            for (int m = 0; m < 4; ++m) { bf16* dst = hid + ((size_t)u.pm * 256 + ai * 128 + wr * 64 + m * 16 + fr) * DFF + hc0;
#pragma unroll
                for (int n = 0; n < 2; ++n) { const f32x4 g = acc[ai][0][m][n], up = acc[ai][1][m][n];
                    v2u pk; pk.x = pk2(siluf(g.x) * up.x, siluf(g.y) * up.y); pk.y = pk2(siluf(g.z) * up.z, siluf(g.w) * up.w); *(v2u*)(dst + 16 * n) = pk; } }
    }
};
struct EpiDown {
    bf16* yc; const int* list; const float* wgt;
    __device__ __forceinline__ void operator()(const f32x4 (&acc)[2][2][4][2], const pg8::Unit& u, int wr, int wc, int fr, int fq) const {
        const int col0 = (u.pn & 3) * 256 + wc * 32 + 4 * fq;
#pragma unroll
        for (int ai = 0; ai < 2; ++ai)
#pragma unroll
            for (int m = 0; m < 4; ++m) { const int pos = u.mt * 256 + ai * 128 + wr * 64 + m * 16 + fr;
                if (pos < u.cnt) { const int ent = list[u.e * pg8::LISTCAP + pos]; const float w = wgt[ent];
                    bf16* dst = yc + ((size_t)(ent & 1) * NR + (ent >> 1)) * D + col0;
#pragma unroll
                    for (int bj = 0; bj < 2; ++bj)
#pragma unroll
                        for (int n = 0; n < 2; ++n) { const f32x4 x = acc[ai][bj][m][n] * w; v2u pk; pk.x = pk2(x.x, x.y); pk.y = pk2(x.z, x.w); *(v2u*)(dst + bj * 128 + n * 16) = pk; } } }
    }
};

__device__ __forceinline__ void p_combine(Frame& F, int layer, int nrows, bool next_norm) {
    const int gw = F.vcu * NWAVES + F.wave, NGW = F.G * NWAVES, lane = F.lane;
    const float* mod = (const float*)(F.ws + WS_MOD) + (size_t)layer * 9 * 6144;
    const float* modn = (const float*)(F.ws + WS_MOD) + (size_t)(layer + 1) * 9 * 6144;
    float* xc = (float*)(F.ws + WS_XC);
    const bf16* yc = (const bf16*)(F.ws + WS_YC);
    for (int r = gw; r < nrows; r += NGW) {
        float* x = r < NLAT ? F.out + (size_t)r * D : xc + (size_t)(r - NLAT) * D;
        const int mi = row_modidx(r);
        const float* gf = mod + (size_t)mi * 6144 + 5120;
        f32x4 v[4], f[4];
#pragma unroll
        for (int j = 0; j < 4; ++j) { const int c = 4 * lane + 256 * j; v[j] = *(const f32x4*)(x + c);
            const v2u y0 = *(const v2u*)(yc + (size_t)r * D + c), y1 = *(const v2u*)(yc + ((size_t)NR + r) * D + c); const f32x4 g = *(const f32x4*)(gf + c);
            f32x4 y; y.x = bflo(y0.x) + bflo(y1.x); y.y = bfhi(y0.x) + bfhi(y1.x); y.z = bflo(y0.y) + bflo(y1.y); y.w = bfhi(y0.y) + bfhi(y1.y);
            v[j] = v[j] + g * y; *(f32x4*)(x + c) = v[j]; }
        if (next_norm) { const float* m = modn + (size_t)mi * 6144; row_norm_store(v, F.in[I_NMIX] + (layer + 1) * D, m, m + 1024, (bf16*)(F.ws + WS_H) + (size_t)r * D, lane, f); }
    }
}

struct EpiWin {
    bf16* base;
    __device__ __forceinline__ void operator()(const f32x4 (&acc)[2][2][4][2], const pg8::Unit& u, int wr, int wc, int fr, int fq) const {
        const int sec = u.pn >> 2; bf16* o = base + (size_t)sec * ((size_t)36 * MiB / 2);
        const int col0 = (u.pn & 3) * 256 + wc * 32 + 4 * fq;
#pragma unroll
        for (int ai = 0; ai < 2; ++ai)
#pragma unroll
            for (int m = 0; m < 4; ++m) { bf16* dst = o + ((size_t)u.pm * 256 + ai * 128 + wr * 64 + m * 16 + fr) * D + col0;
#pragma unroll
                for (int bj = 0; bj < 2; ++bj)
#pragma unroll
                    for (int n = 0; n < 2; ++n) { f32x4 x = acc[ai][bj][m][n]; if (sec == 0) { x.x = siluf(x.x); x.y = siluf(x.y); x.z = siluf(x.z); x.w = siluf(x.w); }
                        v2u pk; pk.x = pk2(x.x, x.y); pk.y = pk2(x.z, x.w); *(v2u*)(dst + bj * 128 + n * 16) = pk; } }
    }
};

constexpr int G_ROW = 272;
constexpr int G_TROW = 144;
constexpr int GL_QT = 0, GL_QD = GL_QT + 64 * G_ROW, GL_KD = GL_QD + 64 * G_ROW, GL_QO = GL_KD + 64 * G_ROW, GL_KO = GL_QO + 32 * G_ROW;
constexpr int GL_KTT = GL_KO + 32 * G_ROW;
constexpr int GL_VT = GL_KTT + 128 * G_TROW;
constexpr int GL_P = GL_VT + 128 * G_TROW;
constexpr int GL_RAWZ = GL_QT;
constexpr int GL_RAWQ = GL_QD;
constexpr int GL_TOT = GL_P + 64 * G_TROW;
constexpr int GL_DEC = GL_TOT + 8 * 128 * 4;
constexpr int GL_END = GL_DEC + 512;
static_assert(GL_END <= RING_BYTES, "gla LDS");

__device__ __forceinline__ void gla_chain(Frame& F, int b, int h, int dir) {
    const int tid = F.tid, lane = F.lane, wid = F.wave, l15 = lane & 15, g4 = lane >> 4;
    LAS unsigned char* lds = F.lds;
    const bf16* QH = (const bf16*)(F.ws + WS_QH); const bf16* VH = (const bf16*)(F.ws + WS_VH); const bf16* ZZ = (const bf16*)(F.ws + (dir ? WS_ZB : WS_ZF));
    bf16* OUT = (bf16*)(F.ws + (dir ? WS_OB : WS_H));
    const float* lbp = (const float*)(F.ws + WS_LB) + dir * 1024 + h * 128;
    const int kp = tid & 63, tb = tid >> 6;
    const float lb0 = lbp[2 * kp], lb1 = lbp[2 * kp + 1];
    const int srow = tid >> 3, sch = tid & 7;
    f32x4 S[8];
#pragma unroll
    for (int i = 0; i < 8; ++i) S[i] = (f32x4){0.f, 0.f, 0.f, 0.f};
    for (int i = tid; i < 64 * G_TROW / 4; i += 512) ((LAS unsigned*)(lds + GL_P))[i] = 0u;
    for (int c = 0; c < 36; ++c) {
        const bool isctx = c < 4;
        const int cc = isctx ? c : c - 4;
        const int nchunk = isctx ? 4 : 32;
        const int chunk = dir ? (nchunk - 1 - cc) : cc;
        const int rowbase = isctx ? (NLAT + b * TCX + chunk * 64) : (b * TL + chunk * 64);
        const int grow = rowbase + (dir ? (63 - srow) : srow);
        {
            const size_t off = (size_t)grow * D + h * 128 + sch * 8;
            const v4u z0 = *(const v4u*)(ZZ + off), z1 = *(const v4u*)(ZZ + off + 64);
            const v4u v0 = *(const v4u*)(VH + off), v1 = *(const v4u*)(VH + off + 64);
            v4u q0 = (v4u){0, 0, 0, 0}, q1 = q0;
            if (!isctx) { q0 = *(const v4u*)(QH + off); q1 = *(const v4u*)(QH + off + 64); }
            *(LAS v4u*)(lds + GL_RAWZ + srow * 256 + sch * 16) = z0; *(LAS v4u*)(lds + GL_RAWZ + srow * 256 + 128 + sch * 16) = z1;
            *(LAS v4u*)(lds + GL_RAWQ + srow * 256 + sch * 16) = q0; *(LAS v4u*)(lds + GL_RAWQ + srow * 256 + 128 + sch * 16) = q1;
            const unsigned vv[8] = {v0.x, v0.y, v0.z, v0.w, v1.x, v1.y, v1.z, v1.w};
#pragma unroll
            for (int j = 0; j < 8; ++j) { const int vcol = (j < 4 ? 0 : 64) + sch * 8 + 2 * (j & 3);
                *(LAS unsigned short*)(lds + GL_VT + vcol * G_TROW + srow * 2) = (unsigned short)(vv[j] & 0xffffu);
                *(LAS unsigned short*)(lds + GL_VT + (vcol + 1) * G_TROW + srow * 2) = (unsigned short)(vv[j] >> 16); }
        }
        __syncthreads();
        {
            float lf0[8], lf1[8], kk0[8], kk1[8], q0[8], q1[8];
            float s0 = 0.f, s1 = 0.f;
#pragma unroll
            for (int i = 0; i < 8; ++i) { const int tau = 8 * tb + i;
                const unsigned zz = *(const LAS unsigned*)(lds + GL_RAWZ + tau * 256 + kp * 4), qq = *(const LAS unsigned*)(lds + GL_RAWQ + tau * 256 + kp * 4);
                const float za = bflo(zz), zb = bfhi(zz);
                const float sa = sigmf(-za), sb = sigmf(-zb);
                kk0[i] = (1.f - lb0) * sa; kk1[i] = (1.f - lb1) * sb;
                s0 += __logf(1.f - kk0[i]); s1 += __logf(1.f - kk1[i]); lf0[i] = s0; lf1[i] = s1;
                q0[i] = bflo(qq); q1[i] = bfhi(qq); }
            *(LAS float*)(lds + GL_TOT + (tb * 128 + 2 * kp) * 4) = s0; *(LAS float*)(lds + GL_TOT + (tb * 128 + 2 * kp + 1) * 4) = s1;
            __syncthreads();
            float pre0 = 0.f, pre1 = 0.f, c15_0 = 0.f, c15_1 = 0.f, c31_0 = 0.f, c31_1 = 0.f, c47_0 = 0.f, c47_1 = 0.f, c63_0 = 0.f, c63_1 = 0.f;
#pragma unroll
            for (int j = 0; j < 8; ++j) { const float t0 = *(const LAS float*)(lds + GL_TOT + (j * 128 + 2 * kp) * 4), t1 = *(const LAS float*)(lds + GL_TOT + (j * 128 + 2 * kp + 1) * 4);
                if (j < tb) { pre0 += t0; pre1 += t1; }
                c63_0 += t0; c63_1 += t1;
                if (j < 2) { c15_0 += t0; c15_1 += t1; } if (j < 4) { c31_0 += t0; c31_1 += t1; } if (j < 6) { c47_0 += t0; c47_1 += t1; } }
            const float m0 = tb < 4 ? c15_0 : c47_0, m1 = tb < 4 ? c15_1 : c47_1;
            unsigned ktt0[4], ktt1[4];
#pragma unroll
            for (int i = 0; i < 8; ++i) { const int tau = 8 * tb + i; const float b0 = pre0 + lf0[i], b1 = pre1 + lf1[i];
                const unsigned qt = pk2(q0[i] * __expf(b0), q1[i] * __expf(b1));
                const unsigned qd = pk2(q0[i] * __expf(b0 - m0), q1[i] * __expf(b1 - m1));
                const unsigned kd = pk2(kk0[i] * __expf(m0 - b0), kk1[i] * __expf(m1 - b1));
                *(LAS unsigned*)(lds + GL_QT + tau * G_ROW + kp * 4) = qt;
                *(LAS unsigned*)(lds + GL_QD + tau * G_ROW + kp * 4) = qd;
                *(LAS unsigned*)(lds + GL_KD + tau * G_ROW + kp * 4) = kd;
                if (tb >= 4) *(LAS unsigned*)(lds + GL_QO + (tau - 32) * G_ROW + kp * 4) = pk2(q0[i] * __expf(b0 - c31_0), q1[i] * __expf(b1 - c31_1));
                else *(LAS unsigned*)(lds + GL_KO + tau * G_ROW + kp * 4) = pk2(kk0[i] * __expf(c31_0 - b0), kk1[i] * __expf(c31_1 - b1));
                const float kt0 = kk0[i] * __expf(c63_0 - b0), kt1 = kk1[i] * __expf(c63_1 - b1);
                if (i & 1) { ktt0[i >> 1] |= f2bf(kt0) << 16; ktt1[i >> 1] |= f2bf(kt1) << 16; } else { ktt0[i >> 1] = f2bf(kt0); ktt1[i >> 1] = f2bf(kt1); } }
            *(LAS v4u*)(lds + GL_KTT + (2 * kp) * G_TROW + tb * 16) = (v4u){ktt0[0], ktt0[1], ktt0[2], ktt0[3]};
            *(LAS v4u*)(lds + GL_KTT + (2 * kp + 1) * G_TROW + tb * 16) = (v4u){ktt1[0], ktt1[1], ktt1[2], ktt1[3]};
            if (tb == 0) { *(LAS float*)(lds + GL_DEC + (2 * kp) * 4) = __expf(c63_0); *(LAS float*)(lds + GL_DEC + (2 * kp + 1) * 4) = __expf(c63_1); }
        }
        __syncthreads();
        if (!isctx) {
            for (int ti = wid; ti < 10; ti += 8) {
                const int tt = ti == 0 ? 0 : ti == 1 ? 1 : ti == 2 ? 1 : ti == 3 ? 2 : ti == 4 ? 3 : ti == 5 ? 3 : ti == 6 ? 2 : ti == 7 ? 2 : 3;
                const int st = ti == 0 ? 0 : ti == 1 ? 0 : ti == 2 ? 1 : ti == 3 ? 2 : ti == 4 ? 2 : ti == 5 ? 3 : ti == 6 ? 0 : ti == 7 ? 1 : ti == 8 ? 0 : 1;
                const bool offd = ti >= 6;
                const LAS unsigned char* qa = offd ? lds + GL_QO + ((tt - 2) * 16 + l15) * G_ROW : lds + GL_QD + (tt * 16 + l15) * G_ROW;
                const LAS unsigned char* ka = offd ? lds + GL_KO + (st * 16 + l15) * G_ROW : lds + GL_KD + (st * 16 + l15) * G_ROW;
                f32x4 a = (f32x4){0.f, 0.f, 0.f, 0.f};
#pragma unroll
                for (int ks = 0; ks < 4; ++ks) { const bf16x8 af = *(const LAS bf16x8*)(qa + ks * 64 + g4 * 16), bfr = *(const LAS bf16x8*)(ka + ks * 64 + g4 * 16);
                    a = __builtin_amdgcn_mfma_f32_16x16x32_bf16(af, bfr, a, 0, 0, 0); }
#pragma unroll
                for (int rg = 0; rg < 4; ++rg) { const int tl = 4 * g4 + rg; float v = a[rg]; if (tt == st && l15 > tl) v = 0.f;
                    *(LAS unsigned short*)(lds + GL_P + (tt * 16 + tl) * G_TROW + (st * 16 + l15) * 2) = (unsigned short)f2bf(v); }
            }
        }
        bf16x8 vf[2];
#pragma unroll
        for (int ks = 0; ks < 2; ++ks) vf[ks] = *(const LAS bf16x8*)(lds + GL_VT + (wid * 16 + l15) * G_TROW + ks * 64 + g4 * 16);
        f32x4 oacc[4];
        if (!isctx) {
            bf16x8 sb[4];
#pragma unroll
            for (int ks = 0; ks < 4; ++ks) { v4u w; w.x = pk2(S[2 * ks][0], S[2 * ks][1]); w.y = pk2(S[2 * ks][2], S[2 * ks][3]); w.z = pk2(S[2 * ks + 1][0], S[2 * ks + 1][1]); w.w = pk2(S[2 * ks + 1][2], S[2 * ks + 1][3]); sb[ks] = __builtin_bit_cast(bf16x8, w); }
#pragma unroll
            for (int tt = 0; tt < 4; ++tt) { f32x4 a = (f32x4){0.f, 0.f, 0.f, 0.f};
#pragma unroll
                for (int ks = 0; ks < 4; ++ks) { const LAS unsigned char* qp = lds + GL_QT + (tt * 16 + l15) * G_ROW + ks * 64 + g4 * 8;
                    const v2u x0 = *(const LAS v2u*)qp, x1 = *(const LAS v2u*)(qp + 32); v4u w; w.x = x0.x; w.y = x0.y; w.z = x1.x; w.w = x1.y;
                    a = __builtin_amdgcn_mfma_f32_16x16x32_bf16(__builtin_bit_cast(bf16x8, w), sb[ks], a, 0, 0, 0); }
                oacc[tt] = a; }
        }
#pragma unroll
        for (int kt = 0; kt < 8; ++kt) { const f32x4 dc = *(const LAS f32x4*)(lds + GL_DEC + (kt * 16 + 4 * g4) * 4);
            f32x4 a = S[kt] * dc;
#pragma unroll
            for (int ks = 0; ks < 2; ++ks) { const bf16x8 kf = *(const LAS bf16x8*)(lds + GL_KTT + (kt * 16 + l15) * G_TROW + ks * 64 + g4 * 16);
                a = __builtin_amdgcn_mfma_f32_16x16x32_bf16(kf, vf[ks], a, 0, 0, 0); }
            S[kt] = a; }
        __syncthreads();
        if (!isctx) {
#pragma unroll
            for (int tt = 0; tt < 4; ++tt) { f32x4 a = oacc[tt];
#pragma unroll
                for (int ks = 0; ks < 2; ++ks) { const bf16x8 pf = *(const LAS bf16x8*)(lds + GL_P + (tt * 16 + l15) * G_TROW + ks * 64 + g4 * 16);
                    a = __builtin_amdgcn_mfma_f32_16x16x32_bf16(pf, vf[ks], a, 0, 0, 0); }
#pragma unroll
                for (int rg = 0; rg < 4; ++rg) { const int tau = tt * 16 + 4 * g4 + rg; const int orow = rowbase + (dir ? (63 - tau) : tau);
                    OUT[(size_t)orow * D + h * 128 + wid * 16 + l15] = (bf16)f2bf(a[rg]); } }
        }
        __syncthreads();
    }
}
__device__ __forceinline__ void p_gla(Frame& F) {
    for (int u = F.vcu; u < 128; u += F.G) gla_chain(F, u >> 4, (u >> 1) & 7, u & 1);
}

__device__ __forceinline__ void p_readout(Frame& F) {
    const int gw = F.vcu * NWAVES + F.wave, NGW = F.G * NWAVES, lane = F.lane;
    bf16* OF = (bf16*)(F.ws + WS_H); const bf16* OB = (const bf16*)(F.ws + WS_OB); const bf16* GH = (const bf16*)(F.ws + WS_GH);
    const float* on = F.in[I_ONORM];
    for (int r = gw; r < NLAT; r += NGW) {
#pragma unroll
        for (int half = 0; half < 2; ++half) {
            const size_t off = (size_t)r * D + half * 512 + lane * 8;
            const v4u a = *(const v4u*)(OF + off), b2 = *(const v4u*)(OB + off), gg = *(const v4u*)(GH + off);
            float o[8]; const unsigned au[4] = {a.x, a.y, a.z, a.w}, bu[4] = {b2.x, b2.y, b2.z, b2.w}, gu[4] = {gg.x, gg.y, gg.z, gg.w};
            float ss = 0.f;
#pragma unroll
            for (int j = 0; j < 4; ++j) { o[2 * j] = bflo(au[j]) + bflo(bu[j]); o[2 * j + 1] = bfhi(au[j]) + bfhi(bu[j]); ss += o[2 * j] * o[2 * j] + o[2 * j + 1] * o[2 * j + 1]; }
            ss += __shfl_xor(ss, 1); ss += __shfl_xor(ss, 2); ss += __shfl_xor(ss, 4); ss += __shfl_xor(ss, 8);
            const float rstd = 1.0f / sqrtf(ss * (1.f / 128.f) + EPS);
            const int d0 = (lane & 15) * 8;
            unsigned w[4];
#pragma unroll
            for (int j = 0; j < 4; ++j) { const float g0 = bflo(gu[j]), g1 = bfhi(gu[j]);
                w[j] = pk2(o[2 * j] * rstd * on[d0 + 2 * j] * siluf(g0), o[2 * j + 1] * rstd * on[d0 + 2 * j + 1] * siluf(g1)); }
            *(v4u*)(OF + off) = (v4u){w[0], w[1], w[2], w[3]};
        }
    }
}

struct Args { const float* in[23]; float* out; unsigned char* ws; int ph_lo, ph_hi; };
constexpr int N_PHASES = 17;
__global__ void __launch_bounds__(NWAVES * 64, 2) fwd_mega(Args args) {
    extern __shared__ __attribute__((aligned(16))) unsigned char lds[];
    Frame F;
    F.lds = (LAS unsigned char*)lds;
    F.MISC = (volatile LAS unsigned*)(F.lds + MISC_OFF);
    F.tid = threadIdx.x; F.lane = F.tid & 63; F.wave = __builtin_amdgcn_readfirstlane(F.tid >> 6);
    F.G = gridDim.x; { const int bx = blockIdx.x; F.vcu = (F.G % 8 == 0) ? (bx % 8) * (F.G / 8) + bx / 8 : bx; }
    F.ws = args.ws; F.ctl = (gu32*)(args.ws + WS_CTL); F.out = args.out;
#pragma unroll
    for (int i = 0; i < 23; ++i) F.in[i] = args.in[i];
    for (int u = F.tid; u < (LDS_BYTES - LDSCTL_OFF) / 4; u += NWAVES * 64) ((LAS unsigned*)(F.lds + LDSCTL_OFF))[u] = 0u;
    __syncthreads();
    XcdBarrier bar; bar.bar = (unsigned*)(F.ctl + CW_BAR); bar.x = 0; bar.st = nullptr;
    if (!MK_PER_PHASE) bar = xcd_barrier_post((unsigned*)(F.ctl + CW_BAR), F.MISC + 8);
    const int lo = args.ph_lo, hi = args.ph_hi;
#ifdef MK_ONLY
#define IN(k) ((k) == MK_ONLY && lo <= (k) && (k) < hi)
#else
#define IN(k) (lo <= (k) && (k) < hi)
#endif
#define SEAM(k) do { if (IN((k) + 1)) xcd_barrier(bar); } while (0)
    const float* modp = (const float*)(F.ws + WS_MOD);
    if (IN(0)) { p0_prep(F); SEAM(0); }
    if (IN(1)) { p_norm_mix0(F); SEAM(1); }
    if (IN(2)) {
        pg8::Gemm g{(const bf16*)(F.ws + WS_H), (const bf16*)(F.ws + WS_WQKV), D, nullptr}; pg8::StaticOrder S; S.init(NR, 3072, F.G, (int)blockIdx.x);
        EpiQKV E{(bf16*)(F.ws + WS_Q), (bf16*)(F.ws + WS_K), (bf16*)(F.ws + WS_VT), F.in[I_QN], F.in[I_KN], (const float*)(F.ws + WS_ROPE), (const float*)(F.ws + WS_ROPE) + 2048 * 32};
        pg8::gemm_phase<EpiQKV, pg8::StaticOrder, false>(F.lds + RING_OFF, g, S, E); SEAM(2); }
    if (IN(3)) { p_attention(F); SEAM(3); }
    if (IN(4)) {
        pg8::Gemm g{(const bf16*)(F.ws + WS_Q), (const bf16*)(F.ws + WS_WO), D, nullptr}; pg8::StaticOrder S; S.init(NR, D, F.G, (int)blockIdx.x);
        EpiResid E{F.in[I_X], F.out, F.in[I_CTX], (float*)(F.ws + WS_XC), modp + 2048};
        pg8::gemm_phase<EpiResid, pg8::StaticOrder, false>(F.lds + RING_OFF, g, S, E); SEAM(4); }
    if (IN(5)) { p_ffn_router(F, 0, NR); SEAM(5); }
    if (IN(6)) {
        MoeOrder S; S.setup(F, 0, 4);
        pg8::Gemm g{(const bf16*)(F.ws + WS_H), (const bf16*)(F.ws + WS_WGU), D, (const int*)(F.ws + WS_LIST)};
        EpiGateUp E{(bf16*)(F.ws + WS_HID)};
        pg8::gemm_phase<EpiGateUp, MoeOrder, true>(F.lds + RING_OFF, g, S, E); SEAM(6); }
    if (IN(7)) {
        MoeOrder S; S.setup(F, 0, 4);
        pg8::Gemm g{(const bf16*)(F.ws + WS_HID), (const bf16*)(F.ws + WS_WD), DFF, nullptr};
        EpiDown E{(bf16*)(F.ws + WS_YC), (const int*)(F.ws + WS_LIST), (const float*)(F.ws + WS_WGT)};
        pg8::gemm_phase<EpiDown, MoeOrder, false>(F.lds + RING_OFF, g, S, E); SEAM(7); }
    if (IN(8)) {
        p_combine(F, 0, NR, true);
        { LAS float* scr = (LAS float*)(F.lds + RING_OFF + F.wave * 16384); const int gw = F.vcu * NWAVES + F.wave, NGW = F.G * NWAVES;
          for (int it = gw; it < MOE_ITEMS; it += NGW) p0_moe_item(F, 1, it, scr); }
        SEAM(8); }
    if (IN(9)) {
        pg8::Gemm g{(const bf16*)(F.ws + WS_H), (const bf16*)(F.ws + WS_WIN), D, nullptr}; pg8::StaticOrder S; S.init(NR, 5120, F.G, (int)blockIdx.x);
        EpiWin E{(bf16*)(F.ws + WS_QH)};
        pg8::gemm_phase<EpiWin, pg8::StaticOrder, false>(F.lds + RING_OFF, g, S, E); SEAM(9); }
    if (IN(10)) { p_gla(F); SEAM(10); }
    if (IN(11)) { p_readout(F); SEAM(11); }
    if (IN(12)) {
        pg8::Gemm g{(const bf16*)(F.ws + WS_H), (const bf16*)(F.ws + WS_WO2), D, nullptr}; pg8::StaticOrder S; S.init(NLAT, D, F.G, (int)blockIdx.x);
        EpiResid E{F.out, F.out, nullptr, nullptr, modp + 9 * 6144 + 2048};
        pg8::gemm_phase<EpiResid, pg8::StaticOrder, false>(F.lds + RING_OFF, g, S, E); SEAM(12); }
    if (IN(13)) { p_ffn_router(F, 1, NLAT); SEAM(13); }
    if (IN(14)) {
        MoeOrder S; S.setup(F, 1, 4);
        pg8::Gemm g{(const bf16*)(F.ws + WS_H), (const bf16*)(F.ws + WS_WGU), D, (const int*)(F.ws + WS_LIST)};
        EpiGateUp E{(bf16*)(F.ws + WS_HID)};
        pg8::gemm_phase<EpiGateUp, MoeOrder, true>(F.lds + RING_OFF, g, S, E); SEAM(14); }
    if (IN(15)) {
        MoeOrder S; S.setup(F, 1, 4);
        pg8::Gemm g{(const bf16*)(F.ws + WS_HID), (const bf16*)(F.ws + WS_WD), DFF, nullptr};
        EpiDown E{(bf16*)(F.ws + WS_YC), (const int*)(F.ws + WS_LIST), (const float*)(F.ws + WS_WGT)};
        pg8::gemm_phase<EpiDown, MoeOrder, false>(F.lds + RING_OFF, g, S, E); SEAM(15); }
    if (IN(16)) { p_combine(F, 1, NLAT, false); }
#undef IN
#undef SEAM
}

extern "C" void kernel_launch(void* const* d_in, const int* in_sizes, int n_in, void* d_out, int out_size, void* d_ws, size_t ws_size, hipStream_t stream) {
    static int grid = 0;
    if (grid == 0) {
        if (n_in != 23 || out_size != NLAT * D || ws_size < WS_END) { fprintf(stderr, "kernel_launch: unexpected problem (n_in %d, out %d, ws %zu)\n", n_in, out_size, ws_size); grid = -1; return; }
        int dev = 0, cus = 0, per_cu = 0;
        if (hipGetDevice(&dev) != hipSuccess || hipDeviceGetAttribute(&cus, hipDeviceAttributeMultiprocessorCount, dev) != hipSuccess) { grid = -1; return; }
        if (hipFuncSetAttribute((const void*)fwd_mega, hipFuncAttributeMaxDynamicSharedMemorySize, LDS_BYTES) != hipSuccess) { fprintf(stderr, "kernel_launch: hipFuncSetAttribute failed\n"); grid = -1; return; }
        if (hipOccupancyMaxActiveBlocksPerMultiprocessor(&per_cu, (const void*)fwd_mega, NWAVES * 64, LDS_BYTES) != hipSuccess || per_cu < 1) fprintf(stderr, "kernel_launch: occupancy query reports %d\n", per_cu);
        (void)hipGetLastError();
        grid = cus;
    }
    if (grid < 0) return;
    if (hipMemsetAsync((char*)d_ws + WS_CTL, 0, CTL_ZERO_BYTES, stream) != hipSuccess) return;
    Args a{};
    for (int i = 0; i < 23; ++i) a.in[i] = (const float*)d_in[i];
    a.out = (float*)d_out; a.ws = (unsigned char*)d_ws;
    const int last = MK_STOP_AFTER < N_PHASES - 1 ? MK_STOP_AFTER : N_PHASES - 1;
#if MK_PER_PHASE
    for (int p = 0; p <= last; ++p) { a.ph_lo = p; a.ph_hi = p + 1; hipLaunchKernelGGL(fwd_mega, dim3(grid), dim3(NWAVES * 64), LDS_BYTES, stream, a); }
#else
    a.ph_lo = 0; a.ph_hi = last + 1;
    hipLaunchKernelGGL(fwd_mega, dim3(grid), dim3(NWAVES * 64), LDS_BYTES, stream, a);
#endif
}
```

```cpp
#include <hip/hip_runtime.h>
#include <cstdio>
#include <cstdint>

#ifndef MK_PER_PHASE
#define MK_PER_PHASE 0
#endif
#ifndef MK_STOP_AFTER
#define MK_STOP_AFTER 99
#endif

namespace pg8 {
#define PG8_LAS __attribute__((address_space(3)))
typedef unsigned short bf16_t;
typedef short bf16x8 __attribute__((ext_vector_type(8)));
typedef float f32x4 __attribute__((ext_vector_type(4)));
typedef unsigned u32x4 __attribute__((ext_vector_type(4)));
constexpr int BM = 256, BK = 64, HALF = 128, HTB = HALF * BK * 2  , STAGE_BYTES = 8 * HTB, NXCD = 8, WGM = 8;

__host__ __device__ __forceinline__ int lds_byte(int r, int c) { const int st = (r >> 4) * 2 + (c >> 5), rr = r & 15, cc = c & 31, ob = rr * 64 + cc * 2; return st * 1024 + (ob ^ (((ob >> 9) & 1) << 5)); }
__host__ __device__ __forceinline__ void stage_rc(int b, int& R, int& C) { const int st = b / 1024, sb = b % 1024, swz = sb ^ (((sb >> 9) & 1) << 5); R = (st >> 1) * 16 + swz / 64; C = (st & 1) * 32 + (swz % 64) / 2; }

struct Unit { int pm, pn, e, mt, cnt; };
struct Gemm { const bf16_t* A; const bf16_t* Bt; int K; const int* gidx; };

struct StaticOrder {
    int nM, nN, nwg, G, c;
    __host__ __device__ void init(int M, int N, int G_, int c_) { nM = M / BM; nN = N / BM; nwg = nM * nN; G = G_; c = c_; }
    __host__ __device__ bool next(int i, Unit& u) const {
        const long L = (long)i * G + c; if (L >= nwg) return false;
        int wgid = (int)L; { const int q = nwg / NXCD, r = nwg % NXCD, xcd = wgid % NXCD, off = wgid / NXCD; wgid = (xcd < r ? xcd * (q + 1) : r * (q + 1) + (xcd - r) * q) + off; }
        const int nig = WGM * nN, gid = wgid / nig, fm = gid * WGM, gsz = (nM - fm) < WGM ? (nM - fm) : WGM;
        u.pm = fm + ((wgid % nig) % gsz); u.pn = (wgid % nig) / gsz; u.e = 0; u.mt = 0; u.cnt = 0; return true;
    }
};
constexpr int LISTCAP = 18432;
template <bool GATHER> __device__ __forceinline__ void unit_voff(const Gemm& g, const Unit& u, int tid, unsigned (&v0)[2], unsigned (&v1)[2]) {
#pragma unroll
    for (int i = 0; i < 2; ++i) { int R, C; stage_rc(tid * 16 + i * 8192, R, C);
        if constexpr (GATHER) {
            const int p0 = u.mt * 256 + R, p1 = p0 + 128;
            const int e0 = p0 < u.cnt ? g.gidx[u.e * LISTCAP + p0] : 0, e1 = p1 < u.cnt ? g.gidx[u.e * LISTCAP + p1] : 0;
            v0[i] = (unsigned)((e0 >> 1) * g.K + C) * 2u; v1[i] = (unsigned)((e1 >> 1) * g.K + C) * 2u;
        } else { v0[i] = (unsigned)(R * g.K + C) * 2u; v1[i] = v0[i]; }
    }
}
template <class Epi, class Sched, bool GATHER>
__device__ __forceinline__ void gemm_phase(PG8_LAS unsigned char* lds, const Gemm g, const Sched& S, const Epi& E) {
    const int tid = threadIdx.x, wid = __builtin_amdgcn_readfirstlane(tid >> 6), lane = tid & 63, wr = wid >> 2, wc = wid & 3, fr = lane & 15, fq = lane >> 4;
    const int K = g.K, nt = K / BK;
    unsigned voffB[2];
#pragma unroll
    for (int i = 0; i < 2; ++i) { int R, C; stage_rc(tid * 16 + i * 8192, R, C); voffB[i] = (unsigned)(R * K + C) * 2u; }
    const size_t kstep = (size_t)(BK * 2);
    const size_t hstep = (size_t)HALF * K * 2;
    const size_t tstep = 2 * hstep;
    const size_t hstepA = GATHER ? 0 : hstep;
    const unsigned ldsw = (unsigned)wid * 1024u;
    const int aoff = lds_byte(wr * 64 + fr, fq * 8), boff = lds_byte(wc * 32 + fr, fq * 8);
#define PG8_SA(b, h) (((b) * 2 + (h)) * HTB)
#define PG8_SB(b, h) ((4 + (b) * 2 + (h)) * HTB)
#define PG8_STAGE(bufoff, gbase, voff) do { _Pragma("unroll") for (int _i = 0; _i < 2; ++_i) \
        __builtin_amdgcn_global_load_lds((const unsigned*)((const char*)(gbase) + (voff)[_i]), (PG8_LAS unsigned*)(lds + (bufoff) + ldsw + _i * 8192), 16, 0, 0); } while (0)
#define PG8_LDA(dst, b, h) do { _Pragma("unroll") for (int m = 0; m < 4; ++m) _Pragma("unroll") for (int k = 0; k < 2; ++k) dst[m][k] = *(const PG8_LAS bf16x8*)(lds + PG8_SA(b, h) + aoff + m * 2048 + k * 1024); } while (0)
#define PG8_LDB(dst, b, h) do { _Pragma("unroll") for (int n = 0; n < 2; ++n) _Pragma("unroll") for (int k = 0; k < 2; ++k) dst[n][k] = *(const PG8_LAS bf16x8*)(lds + PG8_SB(b, h) + boff + n * 2048 + k * 1024); } while (0)
#define PG8_MMA(ai, bj, At, Bt) do { __builtin_amdgcn_s_setprio(1); _Pragma("unroll") for (int m = 0; m < 4; ++m) _Pragma("unroll") for (int n = 0; n < 2; ++n) _Pragma("unroll") for (int k = 0; k < 2; ++k) \
        acc[ai][bj][m][n] = __builtin_amdgcn_mfma_f32_16x16x32_bf16(Bt[n][k], At[m][k], acc[ai][bj][m][n], 0, 0, 0); __builtin_amdgcn_s_setprio(0); } while (0)
#define PG8_WAIT_V(n) asm volatile("s_waitcnt vmcnt(" #n ")" ::: "memory")
#define PG8_WAIT_L(n) asm volatile("s_waitcnt lgkmcnt(" #n ")" ::: "memory")
#define PG8_BAR __builtin_amdgcn_s_barrier()
#define PG8_SCHED __builtin_amdgcn_sched_barrier(0)
    Unit cur, nxt; int ui = 0;
    if (!S.next(0, cur)) return;
    f32x4 acc[2][2][4][2];
#pragma unroll
    for (int a = 0; a < 2; ++a)
#pragma unroll
        for (int b = 0; b < 2; ++b)
#pragma unroll
            for (int m = 0; m < 4; ++m)
#pragma unroll
                for (int n = 0; n < 2; ++n) acc[a][b][m][n] = (f32x4){0.f, 0.f, 0.f, 0.f};
    bf16x8 At[4][2], B0[2][2], B1[2][2];
    unsigned cv0[2], cv1[2], nv0[2], nv1[2];
    unit_voff<GATHER>(g, cur, tid, cv0, cv1);
    const char* cA = (const char*)g.A + (GATHER ? (size_t)0 : (size_t)cur.pm * tstep); const char* cB = (const char*)g.Bt + (size_t)cur.pn * tstep;
    PG8_STAGE(PG8_SB(0, 0), cB, voffB); PG8_STAGE(PG8_SB(0, 1), cB + hstep, voffB); PG8_STAGE(PG8_SA(0, 0), cA, cv0); PG8_STAGE(PG8_SA(0, 1), cA + hstepA, cv1);
    if (wr == 1) PG8_BAR;
    PG8_WAIT_V(2); PG8_BAR;
    PG8_STAGE(PG8_SB(1, 0), cB + kstep, voffB); PG8_STAGE(PG8_SA(1, 0), cA + kstep, cv0); PG8_STAGE(PG8_SB(1, 1), cB + hstep + kstep, voffB);
    PG8_WAIT_V(6); PG8_BAR;
    for (;;) {
        const bool has_next = S.next(ui + 1, nxt);
        const char* nA = has_next ? (const char*)g.A + (GATHER ? (size_t)0 : (size_t)nxt.pm * tstep) : cA; const char* nB = has_next ? (const char*)g.Bt + (size_t)nxt.pn * tstep : cB;
        if (has_next) unit_voff<GATHER>(g, nxt, tid, nv0, nv1); else { nv0[0] = cv0[0]; nv0[1] = cv0[1]; nv1[0] = cv1[0]; nv1[1] = cv1[1]; }
        for (int t = 0; t < nt; t += 2) {
            const bool last = (t == nt - 2);
            const char* a1 = cA + (size_t)(t + 1) * kstep;
            const char* a2 = last ? nA : cA + (size_t)(t + 2) * kstep; const char* b2 = last ? nB : cB + (size_t)(t + 2) * kstep;
            const char* a3 = a2 + kstep; const char* b3 = b2 + kstep;
            unsigned w0[2], w1[2];
            if constexpr (GATHER) { w0[0] = last ? nv0[0] : cv0[0]; w0[1] = last ? nv0[1] : cv0[1]; w1[0] = last ? nv1[0] : cv1[0]; w1[1] = last ? nv1[1] : cv1[1]; }
            else { w0[0] = cv0[0]; w0[1] = cv0[1]; w1[0] = cv0[0]; w1[1] = cv0[1]; }
            PG8_LDB(B0, 0, 0); PG8_LDB(B1, 0, 1); PG8_SCHED; PG8_LDA(At, 0, 0); PG8_STAGE(PG8_SA(1, 1), a1 + hstepA, cv1);
            PG8_WAIT_V(8); PG8_WAIT_L(0); PG8_BAR; PG8_MMA(0, 0, At, B0); PG8_MMA(0, 1, At, B1); PG8_BAR; PG8_SCHED;
            PG8_LDA(At, 0, 1); PG8_STAGE(PG8_SB(0, 0), b2, voffB); PG8_STAGE(PG8_SB(0, 1), b2 + hstep, voffB); PG8_STAGE(PG8_SA(0, 0), a2, w0);
            PG8_WAIT_V(8); PG8_WAIT_L(0); PG8_BAR; PG8_MMA(1, 0, At, B0); PG8_MMA(1, 1, At, B1); PG8_BAR; PG8_SCHED;
            PG8_LDB(B0, 1, 0); PG8_LDB(B1, 1, 1); PG8_SCHED; PG8_LDA(At, 1, 0); PG8_STAGE(PG8_SA(0, 1), a2 + hstepA, w1);
            PG8_WAIT_V(8); PG8_WAIT_L(0); PG8_BAR; PG8_MMA(0, 0, At, B0); PG8_MMA(0, 1, At, B1); PG8_BAR; PG8_SCHED;
            PG8_LDA(At, 1, 1); PG8_STAGE(PG8_SB(1, 0), b3, voffB); PG8_STAGE(PG8_SB(1, 1), b3 + hstep, voffB); PG8_STAGE(PG8_SA(1, 0), a3, w0);
            PG8_WAIT_V(8); PG8_WAIT_L(0); PG8_BAR; PG8_MMA(1, 0, At, B0); PG8_MMA(1, 1, At, B1); PG8_BAR; PG8_SCHED;
        }
        if (wr == 0) PG8_BAR;
        E(acc, cur, wr, wc, fr, fq);
        if (!has_next) break;
#pragma unroll
        for (int a = 0; a < 2; ++a)
#pragma unroll
            for (int b = 0; b < 2; ++b)
#pragma unroll
                for (int m = 0; m < 4; ++m)
#pragma unroll
                    for (int n = 0; n < 2; ++n) acc[a][b][m][n] = (f32x4){0.f, 0.f, 0.f, 0.f};
        cur = nxt; cA = nA; cB = nB; ++ui;
        cv0[0] = nv0[0]; cv0[1] = nv0[1]; cv1[0] = nv1[0]; cv1[1] = nv1[1];
        if (wr == 1) PG8_BAR;
    }
    PG8_WAIT_V(0);
    PG8_BAR;
#undef PG8_SA
#undef PG8_SB
#undef PG8_STAGE
#undef PG8_LDA
#undef PG8_LDB
#undef PG8_MMA
#undef PG8_WAIT_V
#undef PG8_WAIT_L
#undef PG8_BAR
#undef PG8_SCHED
}
}
#define GAS __attribute__((address_space(1)))
#define LAS __attribute__((address_space(3)))
typedef unsigned short bf16;
typedef unsigned v4u __attribute__((ext_vector_type(4)));
typedef float f32x4 __attribute__((ext_vector_type(4)));
typedef short bf16x8 __attribute__((ext_vector_type(8)));
typedef GAS unsigned gu32;
typedef GAS unsigned long long gu64;
#define RLX_AGENT __ATOMIC_RELAXED, __HIP_MEMORY_SCOPE_AGENT
#define LDS_WAIT() asm volatile("s_waitcnt lgkmcnt(0)" ::: "memory")
#define VM_WAIT() asm volatile("s_waitcnt vmcnt(0)" ::: "memory")
__device__ __forceinline__ unsigned long long rt() { return __builtin_amdgcn_s_memrealtime(); }
__device__ __forceinline__ unsigned f2bf(float f) { unsigned u = __builtin_bit_cast(unsigned, f); return (u + 0x7fffu + ((u >> 16) & 1u)) >> 16; }
typedef float f32x2_t __attribute__((ext_vector_type(2))); typedef __bf16 bf16x2_t __attribute__((ext_vector_type(2)));
__device__ __forceinline__ unsigned pk2(float lo, float hi) { f32x2_t v = {lo, hi}; bf16x2_t b = __builtin_convertvector(v, bf16x2_t); return __builtin_bit_cast(unsigned, b); }

#define XB_TMO      128
#define XB_XCNT(j)  (256  + 64 * (j))
#define XB_XSUB(j)  (1280 + 64 * (j))
#define XB_XGEN(j)  (2304 + 64 * (j))
#define XB_TOP      3328
#define XB_TOPGEN   3392
#define XCD_BAR_WORDS 3456
#define XB_SPIN_CAP (1u << 18)

__device__ __forceinline__ unsigned xb_ld(unsigned* p)              { return __hip_atomic_load(p, __ATOMIC_RELAXED, __HIP_MEMORY_SCOPE_AGENT); }
__device__ __forceinline__ unsigned xb_add(unsigned* p, unsigned v) { return __hip_atomic_fetch_add(p, v, __ATOMIC_RELAXED, __HIP_MEMORY_SCOPE_AGENT); }
__device__ __forceinline__ unsigned xb_xcc_id() { return (unsigned)__builtin_amdgcn_s_getreg((3 << 11) | 20) & 0xFu; }
#define XB_SPIN(cond, bar) do { unsigned _sp = 0; while (cond) { __builtin_amdgcn_s_sleep(1); \
    if ((++_sp & 255u) == 0u) { if (xb_ld(&(bar)[XB_TMO])) break; if (_sp > XB_SPIN_CAP) { atomicAdd(&(bar)[XB_TMO], 1u); break; } } } } while (0)

struct XcdBarrier {
    unsigned* bar; unsigned x;
    volatile LAS unsigned* st;
};

__device__ __forceinline__ XcdBarrier xcd_barrier_post(unsigned* bar, volatile LAS unsigned* st) {
    XcdBarrier b; b.bar = bar; b.x = xb_xcc_id(); b.st = st;
    if (threadIdx.x == 0) (void)xb_add(&bar[XB_XCNT(b.x)], 1u);
    return b;
}
__device__ __forceinline__ void xcd_barrier_complete(unsigned* bar, unsigned x, unsigned& nloc, unsigned& nx) {
    const unsigned G = gridDim.x * gridDim.y * gridDim.z;
    unsigned sum, cnt, mine, sp = 0u;
    for (;;) {
        sum = 0u; cnt = 0u; mine = 0u;
#pragma unroll
        for (unsigned j = 0; j < 16; ++j) { const unsigned c = xb_ld(&bar[XB_XCNT(j)]); sum += c; cnt += (c > 0u) ? 1u : 0u; mine = (j == x) ? c : mine; }
        if (sum == G) break;
        __builtin_amdgcn_s_sleep(1);
        if ((++sp & 255u) == 0u) { if (xb_ld(&bar[XB_TMO])) break; if (sp > XB_SPIN_CAP) { atomicAdd(&bar[XB_TMO], 1u); break; } }
    }
    nloc = mine > 0u ? mine : 1u; nx = cnt > 0u ? cnt : 1u;
}

__device__ __forceinline__ void xcd_barrier(const XcdBarrier& b) {
    asm volatile("s_waitcnt vmcnt(0)" ::: "memory");
    __syncthreads();
    if (threadIdx.x == 0) {
        unsigned* bar = b.bar;
        __builtin_amdgcn_s_waitcnt(0);
        unsigned nloc = b.st[0], nx = b.st[1];
        if (nloc == 0u) { xcd_barrier_complete(bar, b.x, nloc, nx); b.st[0] = nloc; b.st[1] = nx; }
        const unsigned old = xb_add(&bar[XB_XSUB(b.x)], 1u);
        const unsigned gen = old / nloc;
        if (old + 1u == (gen + 1u) * nloc) {
            __builtin_amdgcn_fence(__ATOMIC_RELEASE, "agent");
            asm volatile("s_waitcnt vmcnt(0)" ::: "memory");
            const unsigned og = xb_add(&bar[XB_TOP], 1u);
            const unsigned tg = og / nx;
            if (og + 1u == (tg + 1u) * nx) xb_add(&bar[XB_TOPGEN], 1u);
            else XB_SPIN(xb_ld(&bar[XB_TOPGEN]) == tg, bar);
            __builtin_amdgcn_fence(__ATOMIC_ACQUIRE, "agent");
            xb_add(&bar[XB_XGEN(b.x)], 1u);
            asm volatile("s_waitcnt vmcnt(0)" ::: "memory");
        } else {
            XB_SPIN(xb_ld(&bar[XB_XGEN(b.x)]) == gen, bar);
            __builtin_amdgcn_fence(__ATOMIC_ACQUIRE, "agent");
            asm volatile("s_waitcnt vmcnt(0)" ::: "memory");
        }
    }
    __syncthreads();
}

typedef unsigned v2u __attribute__((ext_vector_type(2)));
typedef float f32x16 __attribute__((ext_vector_type(16)));
typedef short s16x4 __attribute__((ext_vector_type(4)));
constexpr int NWAVES = 8;
constexpr int D = 1024, NB = 8, TL = 2048, TCX = 256;
constexpr int NLAT = NB * TL, NCTX = NB * TCX, NR = NLAT + NCTX;
constexpr int SK = TL + TCX;
constexpr float EPS = 1e-6f;
constexpr float C2 = 0.125f * 1.4426950408889634f;
constexpr float LAM_INIT = 0.2f;
constexpr int NEXP = 16, DFF = 512;
constexpr int HIDROWS = 40960;

constexpr size_t MiB = 1u << 20;
constexpr size_t WS_CTL = 0, CTL_ZERO_BYTES = 1 * MiB;
constexpr size_t WS_MOD = 1 * MiB;
constexpr size_t WS_ROPE = 1 * MiB + 512 * 1024;
constexpr size_t WS_LB = 2 * MiB;
constexpr size_t WS_WGT = 2 * MiB + 64 * 1024;
constexpr size_t WS_LIST = 2 * MiB + 512 * 1024;
constexpr size_t WS_WQKV = 4 * MiB, WS_WO = 10 * MiB, WS_WIN = 12 * MiB, WS_WO2 = 22 * MiB, WS_WGU = 24 * MiB, WS_WD = 56 * MiB;
constexpr size_t WS_XC = 72 * MiB;
constexpr size_t WS_H = 80 * MiB;
constexpr size_t WS_OB = 116 * MiB;
constexpr size_t WS_R1 = 148 * MiB;
constexpr size_t WS_Q = WS_R1, WS_K = WS_R1 + 36 * MiB, WS_VT = WS_R1 + 72 * MiB, WS_AO = WS_R1 + 108 * MiB;
constexpr size_t WS_HID = WS_R1, WS_YC = WS_R1 + 40 * MiB;
constexpr size_t WS_QH = WS_R1, WS_VH = WS_R1 + 36 * MiB, WS_ZF = WS_R1 + 72 * MiB, WS_ZB = WS_R1 + 108 * MiB, WS_GH = WS_R1 + 144 * MiB;
constexpr size_t WS_END = WS_R1 + 180 * MiB;
static_assert(WS_YC + (size_t)2 * NR * D * 2 <= WS_END && WS_HID + (size_t)HIDROWS * DFF * 2 <= WS_YC, "ws map");
constexpr int CW_BAR = 4096;
constexpr int CW_CNT = 16384;

constexpr int RING_OFF = 0, RING_BYTES = 131072;
constexpr int LDSCTL_OFF = RING_BYTES, MISC_OFF = LDSCTL_OFF + 320;
constexpr int LDS_BYTES = 147456;
static_assert(MISC_OFF + 1024 <= LDS_BYTES, "LDS map");

struct Frame {
    LAS unsigned char* lds;
    volatile LAS unsigned* MISC;
    gu32* ctl;
    int tid, lane, wave;
    int vcu, G;
    unsigned char* ws;
    const float* in[23];
    float* out;
};
enum { I_X = 0, I_C, I_CTX, I_CCTX, I_ADAW, I_ADAB, I_NMIX, I_NFFN, I_WQKV, I_WO, I_QN, I_KN, I_SUBN, I_LAM, I_WIN, I_WO2, I_ONORM, I_LBG, I_RW, I_RB, I_MG, I_MU, I_MD };

__device__ __forceinline__ float bf2f(unsigned short u) { return __uint_as_float((unsigned)u << 16); }
__device__ __forceinline__ float bflo(unsigned u) { return __uint_as_float(u << 16); }
__device__ __forceinline__ float bfhi(unsigned u) { return __uint_as_float(u & 0xffff0000u); }
__device__ __forceinline__ float wave_sum(float v) {
#pragma unroll
    for (int o = 1; o < 64; o <<= 1) v += __shfl_xor(v, o);
    return v;
}
__device__ __forceinline__ float siluf(float x) { return x / (1.f + __expf(-x)); }
__device__ __forceinline__ float sigmf(float x) { return 1.f / (1.f + __expf(-x)); }
__device__ __forceinline__ int row_batch(int r) { return r < NLAT ? (r >> 11) : ((r - NLAT) >> 8); }
__device__ __forceinline__ int row_modidx(int r) { return r < NLAT ? (r >> 11) : 8; }

__device__ __forceinline__ int tr_drow(int kind, int n) {
    if (kind == 1) return (n & ~255) + 128 * ((n >> 5) & 1) + 32 * ((n >> 6) & 3) + (n & 31);
    if (kind == 2) return (n >> 7) * 256 + (n & 127);
    if (kind == 3) return (n >> 7) * 256 + 128 + (n & 127);
    return n;
}
__device__ __forceinline__ void tr_item(const float* W, int K, int N, bf16* WT, int kind, int item, int lane) {
    const int nkb = K >> 3, nb = item / nkb, kb = item - nb * nkb, k0 = 8 * kb, n0 = 256 * nb + 4 * lane;
    f32x4 v[8];
#pragma unroll
    for (int j = 0; j < 8; ++j) v[j] = *(const f32x4*)(W + (size_t)(k0 + j) * N + n0);
#pragma unroll
    for (int c = 0; c < 4; ++c) { v4u o; o.x = pk2(v[0][c], v[1][c]); o.y = pk2(v[2][c], v[3][c]); o.z = pk2(v[4][c], v[5][c]); o.w = pk2(v[6][c], v[7][c]);
        *(GAS v4u*)(WT + (size_t)tr_drow(kind, n0 + c) * K + k0) = o; }
}
constexpr int MOE_IT_G = 128 * 2, MOE_IT_D = 64 * 4;
constexpr int MOE_ITEMS = 16 * (2 * MOE_IT_G + MOE_IT_D);
__device__ __forceinline__ void p0_moe_item(Frame& F, int layer, int it) {
    bf16* Wgu = (bf16*)(F.ws + WS_WGU); bf16* Wd = (bf16*)(F.ws + WS_WD);
    const int e = it / (2 * MOE_IT_G + MOE_IT_D); int r = it - e * (2 * MOE_IT_G + MOE_IT_D);
    if (r < MOE_IT_G) tr_item(F.in[I_MG] + ((size_t)layer * NEXP + e) * (size_t)(D * DFF), D, DFF, Wgu + (size_t)e * D * D, 2, r, F.lane);
    else if (r < 2 * MOE_IT_G) tr_item(F.in[I_MU] + ((size_t)layer * NEXP + e) * (size_t)(D * DFF), D, DFF, Wgu + (size_t)e * D * D, 3, r - MOE_IT_G, F.lane);
    else tr_item(F.in[I_MD] + ((size_t)layer * NEXP + e) * (size_t)(DFF * D), DFF, D, Wd + (size_t)e * D * DFF, 0, r - 2 * MOE_IT_G, F.lane);
}

__device__ __forceinline__ void p0_prep(Frame& F) {
    const int tid = F.tid, lane = F.lane, wave = F.wave;
    {
        LAS float* sc = (LAS float*)(F.lds);
        LAS float* part = (LAS float*)(F.lds + 40960);
        if ((int)blockIdx.x < 192) {
            for (int i = tid; i < 9 * 1024; i += 512) { const int b = i >> 10, k = i & 1023; const float v = b < 8 ? F.in[I_C][b * 1024 + k] : F.in[I_CCTX][k]; sc[i] = siluf(v); }
            __syncthreads();
            for (int it = blockIdx.x; it < 192; it += F.G) {
                const int layer = it / 96, cg = it % 96, col = cg * 64 + lane;
                const float* W = F.in[I_ADAW] + (size_t)layer * D * 6144 + col;
                float a[9];
#pragma unroll
                for (int b = 0; b < 9; ++b) a[b] = 0.f;
                for (int k0 = wave * 128; k0 < wave * 128 + 128; k0 += 16) { float w[16];
#pragma unroll
                    for (int j = 0; j < 16; ++j) w[j] = W[(size_t)(k0 + j) * 6144];
#pragma unroll
                    for (int b = 0; b < 9; ++b)
#pragma unroll
                        for (int j4 = 0; j4 < 4; ++j4) { const f32x4 s4 = *(const LAS f32x4*)(sc + b * 1024 + k0 + 4 * j4); a[b] += (s4.x * w[4 * j4] + s4.y * w[4 * j4 + 1]) + (s4.z * w[4 * j4 + 2] + s4.w * w[4 * j4 + 3]); } }
#pragma unroll
                for (int b = 0; b < 9; ++b) part[(wave * 9 + b) * 64 + lane] = a[b];
                __syncthreads();
                for (int i = tid; i < 9 * 64; i += 512) { const int b = i >> 6, c = i & 63; float s = 0.f;
#pragma unroll
                    for (int w = 0; w < 8; ++w) s += part[(w * 9 + b) * 64 + c];
                    ((float*)(F.ws + WS_MOD))[((size_t)layer * 9 + b) * 6144 + cg * 64 + c] = s + F.in[I_ADAB][layer * 6144 + cg * 64 + c]; }
                __syncthreads();
            }
        }
        __syncthreads();
    }
    {
        const int gw = F.vcu * NWAVES + wave, NGW = F.G * NWAVES;
        constexpr int I_A = 128 * 12, I_B = 128 * 4, I_C2 = 128 * 20, I_D = 128 * 4;
        constexpr int NIT = I_A + I_B + I_C2 + I_D + MOE_ITEMS;
        for (int it = gw; it < NIT; it += NGW) {
            int r = it;
            if (r < I_A) { tr_item(F.in[I_WQKV], D, 3072, (bf16*)(F.ws + WS_WQKV), 1, r, lane); continue; } r -= I_A;
            if (r < I_B) { tr_item(F.in[I_WO], D, D, (bf16*)(F.ws + WS_WO), 0, r, lane); continue; } r -= I_B;
            if (r < I_C2) { tr_item(F.in[I_WIN], D, 5120, (bf16*)(F.ws + WS_WIN), 0, r, lane); continue; } r -= I_C2;
            if (r < I_D) { tr_item(F.in[I_WO2], D, D, (bf16*)(F.ws + WS_WO2), 0, r, lane); continue; } r -= I_D;
            p0_moe_item(F, 0, r);
        }
    }
    {
        const int gt = blockIdx.x * 512 + tid, NGT = F.G * 512;
        float* cosT = (float*)(F.ws + WS_ROPE); float* sinT = cosT + 2048 * 32;
        for (int i = gt; i < 2048 * 32; i += NGT) { const int t = i >> 5, j = i & 31; const float pos = (j < 16) ? (float)(t >> 6) : (float)(t & 63);
            const float inv = powf(10000.0f, -(float)(j & 15) / 16.0f); const float ang = pos * inv; cosT[i] = cosf(ang); sinT[i] = sinf(ang); }
        float* lb = (float*)(F.ws + WS_LB);
        for (int i = gt; i < 2048; i += NGT) { const int dir = i >> 10, hk = i & 1023; const float g0 = F.in[I_LBG][(dir * 2 + 0) * 1024 + hk], g1 = F.in[I_LBG][(dir * 2 + 1) * 1024 + hk];
            lb[i] = 1.f / (1.f + expf(g0 - g1)); }
        if (gt == 0) {
            const float* lp = F.in[I_LAM]; float s0 = 0.f, s1 = 0.f;
            for (int i = 0; i < 64; ++i) { s0 += lp[i] * lp[64 + i]; s1 += lp[128 + i] * lp[192 + i]; }
            float mq = 0.f, mk = 0.f; for (int i = 0; i < 64; ++i) { mq = fmaxf(mq, fabsf(F.in[I_QN][i])); mk = fmaxf(mk, fabsf(F.in[I_KN][i])); }
            float* sc = (float*)(F.ws + WS_LB + 8192);
            sc[0] = expf(s0) - expf(s1) + LAM_INIT;
            sc[1] = 8.0f * mq * mk * 1.4426950408889634f;
        }
    }
}

__device__ __forceinline__ void row_norm_store(const f32x4 (&v)[4], const float* gamma, const float* sh, const float* sc, bf16* orow, int lane, f32x4 (&f)[4]) {
    float ss = 0.f;
#pragma unroll
    for (int j = 0; j < 4; ++j) ss += (v[j].x * v[j].x + v[j].y * v[j].y) + (v[j].z * v[j].z + v[j].w * v[j].w);
    const float rstd = __builtin_amdgcn_rsqf(wave_sum(ss) * (1.f / D) + EPS);
    GAS unsigned long long* o8 = (GAS unsigned long long*)orow + lane;
#pragma unroll
    for (int j = 0; j < 4; ++j) { const int c = 4 * lane + 256 * j; const f32x4 g = *(const f32x4*)(gamma + c), s1 = *(const f32x4*)(sc + c), s0 = *(const f32x4*)(sh + c);
        f[j] = (v[j] * rstd) * g * (s1 + 1.0f) + s0;
        o8[64 * j] = (unsigned long long)pk2(f[j].x, f[j].y) | ((unsigned long long)pk2(f[j].z, f[j].w) << 32); }
}
__device__ __forceinline__ const float* row_src(Frame& F, int r, const float* xl, const float* xc) { return r < NLAT ? xl + (size_t)r * D : xc + (size_t)(r - NLAT) * D; }

__device__ __forceinline__ void p_norm_mix0(Frame& F) {
    const int gw = F.vcu * NWAVES + F.wave, NGW = F.G * NWAVES;
    const float* mod = (const float*)(F.ws + WS_MOD);
    f32x4 v[4], vn[4], f[4];
    int r = gw;
    if (r < NR) { const float* src = row_src(F, r, F.in[I_X], F.in[I_CTX]);
#pragma unroll
        for (int j = 0; j < 4; ++j) v[j] = *(const f32x4*)(src + 4 * F.lane + 256 * j); }
    for (; r < NR; r += NGW) {
        const int rn = r + NGW;
        if (rn < NR) { const float* src = row_src(F, rn, F.in[I_X], F.in[I_CTX]);
#pragma unroll
            for (int j = 0; j < 4; ++j) vn[j] = *(const f32x4*)(src + 4 * F.lane + 256 * j); }
        const float* m = mod + (size_t)(0 * 9 + row_modidx(r)) * 6144;
        row_norm_store(v, F.in[I_NMIX], m, m + 1024, (bf16*)(F.ws + WS_H) + (size_t)r * D, F.lane, f);
#pragma unroll
        for (int j = 0; j < 4; ++j) v[j] = vn[j];
    }
}

struct EpiQKV {
    bf16* Q; bf16* K; bf16* Vt; const float* qn; const float* kn; const float* cosT; const float* sinT;
    __device__ __forceinline__ void operator()(const f32x4 (&acc)[2][2][4][2], const pg8::Unit& u, int wr, int wc, int fr, int fq) const {
        const int sec = u.pn >> 2, ts = u.pn & 3, h = 2 * ts + (wc >> 1), mp = wc & 1;
        const bool lat = u.pm < 64;
        const int b = lat ? (u.pm >> 3) : (u.pm - 64);
        const int s0 = lat ? ((u.pm & 7) << 8) : TL;
        if (sec < 2) {
            const float* wn = sec == 0 ? qn : kn;
            f32x4 w[2][2];
#pragma unroll
            for (int bj = 0; bj < 2; ++bj)
#pragma unroll
                for (int n = 0; n < 2; ++n) w[bj][n] = *(const f32x4*)(wn + 32 * bj + 16 * n + 4 * fq);
#pragma unroll
            for (int ai = 0; ai < 2; ++ai)
#pragma unroll
                for (int m = 0; m < 4; ++m) {
                    const int rloc = ai * 128 + wr * 64 + m * 16 + fr, r = u.pm * 256 + rloc;
                    float ss = 0.f;
#pragma unroll
                    for (int bj = 0; bj < 2; ++bj)
#pragma unroll
                        for (int n = 0; n < 2; ++n) { const f32x4 x = acc[ai][bj][m][n]; ss += (x.x * x.x + x.y * x.y) + (x.z * x.z + x.w * x.w); }
                    ss += __shfl_xor(ss, 16); ss += __shfl_xor(ss, 32);
                    const float rstd = 1.0f / sqrtf(ss * (1.f / 64.f) + EPS);
                    f32x4 y[2][2];
#pragma unroll
                    for (int bj = 0; bj < 2; ++bj)
#pragma unroll
                        for (int n = 0; n < 2; ++n) y[bj][n] = acc[ai][bj][m][n] * rstd * w[bj][n];
                    if (lat) { const int t = r & (TL - 1);
#pragma unroll
                        for (int n = 0; n < 2; ++n) { const f32x4 cs = *(const f32x4*)(cosT + t * 32 + 16 * n + 4 * fq), sn = *(const f32x4*)(sinT + t * 32 + 16 * n + 4 * fq);
                            const f32x4 x1 = y[0][n], x2 = y[1][n]; y[0][n] = x1 * cs - x2 * sn; y[1][n] = x2 * cs + x1 * sn; } }
                    bf16* dst = sec == 0 ? Q + (size_t)r * D + h * 128 + mp * 64 : K + ((size_t)b * SK + s0 + rloc) * D + h * 128 + mp * 64;
                    const float sc = sec == 0 ? C2 : 1.0f;
#pragma unroll
                    for (int bj = 0; bj < 2; ++bj)
#pragma unroll
                        for (int n = 0; n < 2; ++n) { const f32x4 o = y[bj][n] * sc; v2u pk; pk.x = pk2(o.x, o.y); pk.y = pk2(o.z, o.w); *(v2u*)(dst + 32 * bj + 16 * n + 4 * fq) = pk; }
                }
        } else {
            bf16* vb = Vt + ((size_t)(b * 8 + h) * 128 + mp * 64) * SK + s0;
#pragma unroll
            for (int ai = 0; ai < 2; ++ai)
#pragma unroll
                for (int m = 0; m < 4; ++m) { const int rloc = ai * 128 + wr * 64 + m * 16 + fr;
#pragma unroll
                    for (int bj = 0; bj < 2; ++bj)
#pragma unroll
                        for (int n = 0; n < 2; ++n) { const f32x4 x = acc[ai][bj][m][n]; bf16* p = vb + (size_t)(32 * bj + 16 * n + 4 * fq) * SK + rloc;
                            const unsigned a01 = pk2(x.x, x.y), a23 = pk2(x.z, x.w); p[0] = (bf16)(a01 & 0xffffu); p[SK] = (bf16)(a01 >> 16); p[2 * SK] = (bf16)(a23 & 0xffffu); p[3 * SK] = (bf16)(a23 >> 16); } }
        }
    }
};

constexpr int ATT_K1 = 8192, ATT_VT = 16384, ATT_STAGE = 32768;
static_assert(2 * ATT_STAGE <= RING_BYTES, "attention LDS");
__device__ __forceinline__ unsigned cvtpk(float lo, float hi) { return pk2(lo, hi); }
__device__ __forceinline__ void attn_unit(Frame& F, int b, int h, int qrow0, int kt0, int nkt, const float lam) {
    const int lane = F.lane, wid = F.wave, r32 = lane & 31, hi = lane >> 5;
    const bf16* Qg = (const bf16*)(F.ws + WS_Q); const bf16* Kg = (const bf16*)(F.ws + WS_K); const bf16* Vg = (const bf16*)(F.ws + WS_VT);
    bf16* Og = (bf16*)(F.ws + WS_AO);
    const int r = qrow0 + wid * 32 + r32;
    bf16x8 qf[2][4];
#pragma unroll
    for (int mp = 0; mp < 2; ++mp)
#pragma unroll
        for (int ks = 0; ks < 4; ++ks) qf[mp][ks] = *(const bf16x8*)(Qg + (size_t)r * D + h * 128 + mp * 64 + ks * 16 + hi * 8);
    f32x16 o[2][4];
#pragma unroll
    for (int mp = 0; mp < 2; ++mp)
#pragma unroll
        for (int bl = 0; bl < 4; ++bl)
#pragma unroll
            for (int i = 0; i < 16; ++i) o[mp][bl][i] = 0.f;
    float l0 = 0.f, l1 = 0.f;
    const int sb_ = lane >> 3, sc_ = (lane & 7) ^ sb_ ^ (wid & 3);
    const bf16* ksrc = Kg + ((size_t)b * SK + 8 * wid + sb_) * D + h * 128 + sc_ * 8;
    const bf16* vsrc = Vg + ((size_t)(b * 8 + h) * 128 + 8 * wid + sb_) * SK + sc_ * 8;
    LAS unsigned char* lds = F.lds;
    const unsigned dbase = (unsigned)wid * 1024u;
#define ATT_DMA(kt, st) do { \
        __builtin_amdgcn_global_load_lds((const unsigned*)(ksrc + (size_t)(kt) * 64 * D), (LAS unsigned*)(lds + (st) * ATT_STAGE + dbase), 16, 0, 0); \
        __builtin_amdgcn_global_load_lds((const unsigned*)(ksrc + (size_t)(kt) * 64 * D + 64), (LAS unsigned*)(lds + (st) * ATT_STAGE + ATT_K1 + dbase), 16, 0, 0); \
        __builtin_amdgcn_global_load_lds((const unsigned*)(vsrc + (size_t)(kt) * 64), (LAS unsigned*)(lds + (st) * ATT_STAGE + ATT_VT + dbase), 16, 0, 0); \
        __builtin_amdgcn_global_load_lds((const unsigned*)(vsrc + (size_t)(kt) * 64 + (size_t)64 * SK), (LAS unsigned*)(lds + (st) * ATT_STAGE + ATT_VT + 8192 + dbase), 16, 0, 0); } while (0)
    const int sw = (r32 & 7) ^ ((r32 >> 3) & 3);
    ATT_DMA(kt0, 0);
    asm volatile("s_waitcnt vmcnt(0)" ::: "memory");
    __syncthreads();
    for (int t = 0; t < nkt; ++t) {
        const int st = t & 1;
        if (t + 1 < nkt) ATT_DMA(kt0 + t + 1, st ^ 1);
        const LAS unsigned char* kb = lds + st * ATT_STAGE;
#pragma unroll 1
        for (int sub = 0; sub < 2; ++sub) {
            unsigned pk[2][8];
#pragma unroll
            for (int mp = 0; mp < 2; ++mp) {
                f32x16 s = {0.f,0.f,0.f,0.f,0.f,0.f,0.f,0.f,0.f,0.f,0.f,0.f,0.f,0.f,0.f,0.f};
#pragma unroll
                for (int ks = 0; ks < 4; ++ks) { const bf16x8 kf = *(const LAS bf16x8*)(kb + mp * ATT_K1 + (sub * 32 + r32) * 128 + (((2 * ks + hi) ^ sw) << 4));
                    s = __builtin_amdgcn_mfma_f32_32x32x16_bf16(kf, qf[mp][ks], s, 0, 0, 0); }
                float ls = 0.f;
#pragma unroll
                for (int i = 0; i < 16; ++i) { s[i] = __builtin_amdgcn_exp2f(s[i]); ls += s[i]; }
                if (mp == 0) l0 += ls; else l1 += ls;
#pragma unroll
                for (int i = 0; i < 8; ++i) pk[mp][i] = cvtpk(s[2 * i], s[2 * i + 1]);
            }
#pragma unroll
            for (int bl = 0; bl < 4; ++bl) {
              __builtin_amdgcn_sched_barrier(0);
#pragma unroll
                for (int ks = 0; ks < 2; ++ks) {
                    const LAS unsigned char* vrow = kb + ATT_VT + (bl * 32 + r32) * 128 + hi * 8;
                    const int c1 = 4 * sub + 2 * ks;
                    const v2u va = *(const LAS v2u*)(vrow + ((c1 ^ sw) << 4)), vb = *(const LAS v2u*)(vrow + (((c1 + 1) ^ sw) << 4));
                    v4u vv; vv.x = va.x; vv.y = va.y; vv.z = vb.x; vv.w = vb.y;
                    const bf16x8 vf = __builtin_bit_cast(bf16x8, vv);
                    v4u p0; p0.x = pk[0][4 * ks]; p0.y = pk[0][4 * ks + 1]; p0.z = pk[0][4 * ks + 2]; p0.w = pk[0][4 * ks + 3];
                    v4u p1; p1.x = pk[1][4 * ks]; p1.y = pk[1][4 * ks + 1]; p1.z = pk[1][4 * ks + 2]; p1.w = pk[1][4 * ks + 3];
                    o[0][bl] = __builtin_amdgcn_mfma_f32_32x32x16_bf16(vf, __builtin_bit_cast(bf16x8, p0), o[0][bl], 0, 0, 0);
                    o[1][bl] = __builtin_amdgcn_mfma_f32_32x32x16_bf16(vf, __builtin_bit_cast(bf16x8, p1), o[1][bl], 0, 0, 0);
                }
            }
        }
        asm volatile("s_waitcnt vmcnt(0)" ::: "memory");
        __syncthreads();
    }
#undef ATT_DMA
    l0 += __shfl_xor(l0, 32); l1 += __shfl_xor(l1, 32);
    const float i0 = 1.0f / l0, i1 = lam / l1;
    float ss = 0.f;
#pragma unroll
    for (int bl = 0; bl < 4; ++bl)
#pragma unroll
        for (int i = 0; i < 16; ++i) { const float v = o[0][bl][i] * i0 - o[1][bl][i] * i1; o[0][bl][i] = v; ss += v * v; }
    ss += __shfl_xor(ss, 32);
    const float rstd = (1.0f - LAM_INIT) / sqrtf(ss * (1.f / 128.f) + EPS);
    const float* sn = F.in[I_SUBN];
    bf16* orow = Og + (size_t)r * D + h * 128;
#pragma unroll
    for (int bl = 0; bl < 4; ++bl)
#pragma unroll
        for (int g = 0; g < 4; ++g) { const int dv = bl * 32 + 8 * g + 4 * hi; const f32x4 w = *(const f32x4*)(sn + dv);
            v2u pkk; pkk.x = pk2(o[0][bl][4 * g] * rstd * w.x, o[0][bl][4 * g + 1] * rstd * w.y); pkk.y = pk2(o[0][bl][4 * g + 2] * rstd * w.z, o[0][bl][4 * g + 3] * rstd * w.w);
            *(v2u*)(orow + dv) = pkk; }
}
__device__ __forceinline__ void p_attention(Frame& F) {
    const float lam = ((const float*)(F.ws + WS_LB + 8192))[0];
    for (int u = F.vcu; u < 576; u += F.G) {
        if (u < 512) { const int bh = u >> 3, qb = u & 7, b = bh >> 3, h = bh & 7; attn_unit(F, b, h, b * TL + qb * 256, 0, SK / 64, lam); }
        else { const int bh = u - 512, b = bh >> 3, h = bh & 7; attn_unit(F, b, h, NLAT + b * TCX, TL / 64, TCX / 64, lam); }
    }
}

struct EpiResid {
    const float* src_l; float* dst_l; const float* src_c; float* dst_c; const float* modg;
    __device__ __forceinline__ void operator()(const f32x4 (&acc)[2][2][4][2], const pg8::Unit& u, int wr, int wc, int fr, int fq) const {
        const bool lat = u.pm < 64;
        const int mi = lat ? (u.pm >> 3) : 8;
        const float* src = lat ? src_l + (size_t)u.pm * 256 * D : src_c + (size_t)(u.pm - 64) * 256 * D;
        float* dst = lat ? dst_l + (size_t)u.pm * 256 * D : dst_c + (size_t)(u.pm - 64) * 256 * D;
        const int col0 = u.pn * 256 + wc * 32 + 4 * fq;
        f32x4 gv[2][2];
#pragma unroll
        for (int bj = 0; bj < 2; ++bj)
#pragma unroll
            for (int n = 0; n < 2; ++n) gv[bj][n] = *(const f32x4*)(modg + (size_t)mi * 6144 + col0 + bj * 128 + n * 16);
#pragma unroll
        for (int ai = 0; ai < 2; ++ai)
#pragma unroll
            for (int m = 0; m < 4; ++m) { const size_t off = (size_t)(ai * 128 + wr * 64 + m * 16 + fr) * D + col0;
#pragma unroll
                for (int bj = 0; bj < 2; ++bj)
#pragma unroll
                    for (int n = 0; n < 2; ++n) { const f32x4 xs = *(const f32x4*)(src + off + bj * 128 + n * 16); *(f32x4*)(dst + off + bj * 128 + n * 16) = xs + gv[bj][n] * acc[ai][bj][m][n]; } }
    }
};

__device__ __forceinline__ void p_ffn_router(Frame& F, int layer, int nrows) {
    const int tid = F.tid, lane = F.lane;
    LAS float* rwT = (LAS float*)(F.lds);
    volatile LAS unsigned* nloc = (volatile LAS unsigned*)(F.lds + 65536); volatile LAS unsigned* loc = nloc + 64;
    if (tid < 64) nloc[tid] = 0u;
    volatile LAS float* lgw = (volatile LAS float*)(F.lds + 65536 + 4096) + F.wave * 16;
    float rb[16];
#pragma unroll
    for (int e = 0; e < 16; ++e) rb[e] = F.in[I_RB][e];
    for (int i = tid; i < 16 * 1024; i += 512) { const int k = i >> 4, e = i & 15; rwT[e * 1024 + k] = F.in[I_RW][i]; }
    __syncthreads();
    const int gw = F.vcu * NWAVES + F.wave, NGW = F.G * NWAVES;
    const float* mod = (const float*)(F.ws + WS_MOD) + (size_t)layer * 9 * 6144;
    const float* gam = F.in[I_NFFN] + layer * D;
    const float* xc = (const float*)(F.ws + WS_XC);
    gu32* cnt = F.ctl + CW_CNT + layer * 16 * 64;
    int* list = (int*)(F.ws + WS_LIST); float* wgt = (float*)(F.ws + WS_WGT);
    f32x4 v[4], vn[4], f[4];
    int r = gw;
    if (r < nrows) { const float* src = row_src(F, r, F.out, xc);
#pragma unroll
        for (int j = 0; j < 4; ++j) v[j] = *(const f32x4*)(src + 4 * lane + 256 * j); }
    for (; r < nrows; r += NGW) {
        { const int rn = r + NGW; if (rn < nrows) { const float* src = row_src(F, rn, F.out, xc);
#pragma unroll
            for (int j = 0; j < 4; ++j) vn[j] = *(const f32x4*)(src + 4 * lane + 256 * j); } }
        const float* m = mod + (size_t)row_modidx(r) * 6144;
        row_norm_store(v, gam, m + 3072, m + 4096, (bf16*)(F.ws + WS_H) + (size_t)r * D, lane, f);
        float p[16];
#pragma unroll
        for (int e = 0; e < 16; ++e) { if ((e & 3) == 0) __builtin_amdgcn_sched_barrier(0);
            float a = 0.f;
#pragma unroll
            for (int j = 0; j < 4; ++j) { const f32x4 w = *(const LAS f32x4*)(rwT + e * 1024 + 4 * lane + 256 * j); a += (f[j].x * w.x + f[j].y * w.y) + (f[j].z * w.z + f[j].w * w.w); }
            p[e] = a; }
        float q8[8], q4[4], q2[2], q1;
        { const bool hb = (lane & 32) != 0;
#pragma unroll
          for (int i = 0; i < 8; ++i) { const float snd = hb ? p[i] : p[i + 8], kp = hb ? p[i + 8] : p[i]; q8[i] = kp + __shfl_xor(snd, 32); } }
        { const bool hb = (lane & 16) != 0;
#pragma unroll
          for (int i = 0; i < 4; ++i) { const float snd = hb ? q8[i] : q8[i + 4], kp = hb ? q8[i + 4] : q8[i]; q4[i] = kp + __shfl_xor(snd, 16); } }
        { const bool hb = (lane & 8) != 0;
#pragma unroll
          for (int i = 0; i < 2; ++i) { const float snd = hb ? q4[i] : q4[i + 2], kp = hb ? q4[i + 2] : q4[i]; q2[i] = kp + __shfl_xor(snd, 8); } }
        { const bool hb = (lane & 4) != 0; const float snd = hb ? q2[0] : q2[1], kp = hb ? q2[1] : q2[0]; q1 = kp + __shfl_xor(snd, 4); }
        q1 += __shfl_xor(q1, 1); q1 += __shfl_xor(q1, 2);
        const float myaff = __builtin_amdgcn_rcpf(1.f + __expf(-q1));
        if ((lane & 3) == 0) lgw[lane >> 2] = myaff;
        float aff[16];
#pragma unroll
        for (int e4 = 0; e4 < 4; ++e4) { const f32x4 t4 = *(const volatile LAS f32x4*)(lgw + 4 * e4); aff[4 * e4] = t4.x; aff[4 * e4 + 1] = t4.y; aff[4 * e4 + 2] = t4.z; aff[4 * e4 + 3] = t4.w; }
        float best = -1e30f; int bg = 0; float gb[4] = {0.f, 0.f, 0.f, 0.f}, ga[4] = {0.f, 0.f, 0.f, 0.f};
#pragma unroll
        for (int g = 0; g < 4; ++g) {
            const float a = aff[4 * g] + rb[4 * g], b2 = aff[4 * g + 1] + rb[4 * g + 1], c = aff[4 * g + 2] + rb[4 * g + 2], d = aff[4 * g + 3] + rb[4 * g + 3];
            const float hi1 = fmaxf(a, b2), lo1 = fminf(a, b2), hi2 = fmaxf(c, d), lo2 = fminf(c, d);
            const float top = fmaxf(hi1, hi2), sec = fmaxf(fminf(hi1, hi2), fmaxf(lo1, lo2)); const float sc = top + sec;
            if (sc > best) { best = sc; bg = g; gb[0] = a; gb[1] = b2; gb[2] = c; gb[3] = d; ga[0] = aff[4 * g]; ga[1] = aff[4 * g + 1]; ga[2] = aff[4 * g + 2]; ga[3] = aff[4 * g + 3]; } }
        int i0 = 0; float b0 = gb[0];
#pragma unroll
        for (int j = 1; j < 4; ++j) if (gb[j] > b0) { b0 = gb[j]; i0 = j; }
        int i1 = -1; float b1 = -1e30f;
#pragma unroll
        for (int j = 0; j < 4; ++j) if (j != i0 && gb[j] > b1) { b1 = gb[j]; i1 = j; }
        const float a0 = i0 == 0 ? ga[0] : i0 == 1 ? ga[1] : i0 == 2 ? ga[2] : ga[3];
        const float a1 = i1 == 0 ? ga[0] : i1 == 1 ? ga[1] : i1 == 2 ? ga[2] : ga[3];
        const float inv = 1.0f / (a0 + a1);
        if (lane == 0) {
            const int e0 = bg * 4 + i0, e1 = bg * 4 + i1;
            const unsigned k = __hip_atomic_fetch_add((LAS unsigned*)nloc, 2u, __ATOMIC_RELAXED, __HIP_MEMORY_SCOPE_WORKGROUP);
            const unsigned r0 = __hip_atomic_fetch_add((LAS unsigned*)(nloc + 16 + e0), 1u, __ATOMIC_RELAXED, __HIP_MEMORY_SCOPE_WORKGROUP);
            const unsigned r1 = __hip_atomic_fetch_add((LAS unsigned*)(nloc + 16 + e1), 1u, __ATOMIC_RELAXED, __HIP_MEMORY_SCOPE_WORKGROUP);
            loc[k] = (unsigned)(r * 2) | ((unsigned)e0 << 16) | (r0 << 20); loc[k + 1] = (unsigned)(r * 2 + 1) | ((unsigned)e1 << 16) | (r1 << 20);
            wgt[r * 2] = a0 * inv; wgt[r * 2 + 1] = a1 * inv;
        }
#pragma unroll
        for (int j = 0; j < 4; ++j) v[j] = vn[j];
    }
    __syncthreads();
    if (tid < 16) { const unsigned c = nloc[16 + tid]; nloc[32 + tid] = c ? __hip_atomic_fetch_add(cnt + tid * 64, c, RLX_AGENT) : 0u; }
    __syncthreads();
    { const unsigned n = *nloc;
      for (unsigned i = tid; i < n; i += 512) { const unsigned en = loc[i]; const unsigned e = (en >> 16) & 15u; list[e * pg8::LISTCAP + (int)(nloc[32 + e] + (en >> 20))] = (int)(en & 0xffffu); } }
    __syncthreads();
}

struct MoeOrder {
    volatile LAS int* tb;
    int G, c, NT;
    __device__ __forceinline__ void setup(Frame& F, int layer, int nt_) {
        tb = (volatile LAS int*)(F.MISC + 16); G = F.G; c = (int)blockIdx.x; NT = nt_;
        __syncthreads();
        if (F.tid == 0) { int acc = 0;
            for (int e = 0; e < 16; ++e) { const int n = (int)__hip_atomic_load(F.ctl + CW_CNT + (layer * 16 + e) * 64, RLX_AGENT); tb[e] = acc; tb[17 + e] = n; acc += (n + 255) >> 8; }
            tb[16] = acc; }
        __syncthreads();
    }
    __device__ __forceinline__ bool next(int i, pg8::Unit& u) const {
        const int L = i * G + c, tot = tb[16];
        if (L >= tot * NT) return false;
        const int T = L / NT, nt = L - T * NT;
        int e = 0;
#pragma unroll
        for (int k = 1; k < 16; ++k) e += (tb[k] <= T) ? 1 : 0;
        u.pm = T; u.pn = e * NT + nt; u.e = e; u.mt = T - tb[e]; u.cnt = tb[17 + e]; return true;
    }
};
struct EpiGateUp {
    bf16* hid;
    __device__ __forceinline__ void operator()(const f32x4 (&acc)[2][2][4][2], const pg8::Unit& u, int wr, int wc, int fr, int fq) const {
        const int hc0 = (u.pn & 3) * 128 + wc * 32 + 4 * fq;
#pragma unroll
        for (int ai = 0; ai < 2; ++ai)
#pragma unroll
            for (int m = 0; m < 4; ++m) { bf16* dst = hid + ((size_t)u.pm * 256 + ai * 128 + wr * 64 + m * 16 + fr) * DFF + hc0;
#pragma unroll
                for (int n = 0; n < 2; ++n) { const f32x4 g = acc[ai][0][m][n], up = acc[ai][1][m][n];
                    v2u pk; pk.x = pk2(siluf(g.x) * up.x, siluf(g.y) * up.y); pk.y = pk2(siluf(g.z) * up.z, siluf(g.w) * up.w); *(v2u*)(dst + 16 * n) = pk; } }
    }
};
struct EpiDown {
    bf16* yc; const int* list; const float* wgt;
    __device__ __forceinline__ void operator()(const f32x4 (&acc)[2][2][4][2], const pg8::Unit& u, int wr, int wc, int fr, int fq) const {
        const int col0 = (u.pn & 3) * 256 + wc * 32 + 4 * fq;
#pragma unroll
        for (int ai = 0; ai < 2; ++ai)
#pragma unroll
            for (int m = 0; m < 4; ++m) { const int pos = u.mt * 256 + ai * 128 + wr * 64 + m * 16 + fr;
                if (pos < u.cnt) { const int ent = list[u.e * pg8::LISTCAP + pos]; const float w = wgt[ent];
                    bf16* dst = yc + ((size_t)(ent & 1) * NR + (ent >> 1)) * D + col0;
#pragma unroll
                    for (int bj = 0; bj < 2; ++bj)
#pragma unroll
                        for (int n = 0; n < 2; ++n) { const f32x4 x = acc[ai][bj][m][n] * w; v2u pk; pk.x = pk2(x.x, x.y); pk.y = pk2(x.z, x.w); *(v2u*)(dst + bj * 128 + n * 16) = pk; } } }
    }
};

__device__ __forceinline__ void p_combine(Frame& F, int layer, int nrows, bool next_norm) {
    const int gw = F.vcu * NWAVES + F.wave, NGW = F.G * NWAVES, lane = F.lane;
    const float* mod = (const float*)(F.ws + WS_MOD) + (size_t)layer * 9 * 6144;
    const float* modn = (const float*)(F.ws + WS_MOD) + (size_t)(layer + 1) * 9 * 6144;
    float* xc = (float*)(F.ws + WS_XC);
    const bf16* yc = (const bf16*)(F.ws + WS_YC);
    f32x4 v[4], vn[4], f[4]; v2u y0[4], y1[4], y0n[4], y1n[4];
#define CMB_LOAD(V, Y0, Y1, rr) do { const float* x_ = (rr) < NLAT ? F.out + (size_t)(rr) * D : xc + (size_t)((rr) - NLAT) * D; \
        _Pragma("unroll") for (int j = 0; j < 4; ++j) { const int c = 4 * lane + 256 * j; V[j] = *(const f32x4*)(x_ + c); Y0[j] = *(const v2u*)(yc + (size_t)(rr) * D + c); Y1[j] = *(const v2u*)(yc + ((size_t)NR + (rr)) * D + c); } } while (0)
    int r = gw;
    if (r < nrows) CMB_LOAD(v, y0, y1, r);
    for (; r < nrows; r += NGW) {
        { const int rn = r + NGW; if (rn < nrows) CMB_LOAD(vn, y0n, y1n, rn); }
        float* x = r < NLAT ? F.out + (size_t)r * D : xc + (size_t)(r - NLAT) * D;
        const int mi = row_modidx(r);
        const float* gf = mod + (size_t)mi * 6144 + 5120;
#pragma unroll
        for (int j = 0; j < 4; ++j) { const int c = 4 * lane + 256 * j; const f32x4 g = *(const f32x4*)(gf + c);
            f32x4 y; y.x = bflo(y0[j].x) + bflo(y1[j].x); y.y = bfhi(y0[j].x) + bfhi(y1[j].x); y.z = bflo(y0[j].y) + bflo(y1[j].y); y.w = bfhi(y0[j].y) + bfhi(y1[j].y);
            v[j] = v[j] + g * y; *(f32x4*)(x + c) = v[j]; }
        if (next_norm) { const float* m = modn + (size_t)mi * 6144; row_norm_store(v, F.in[I_NMIX] + (layer + 1) * D, m, m + 1024, (bf16*)(F.ws + WS_H) + (size_t)r * D, lane, f); }
#pragma unroll
        for (int j = 0; j < 4; ++j) { v[j] = vn[j]; y0[j] = y0n[j]; y1[j] = y1n[j]; }
    }
#undef CMB_LOAD
}

struct EpiWin {
    bf16* base;
    __device__ __forceinline__ void operator()(const f32x4 (&acc)[2][2][4][2], const pg8::Unit& u, int wr, int wc, int fr, int fq) const {
        const int sec = u.pn >> 2; bf16* o = base + (size_t)sec * ((size_t)36 * MiB / 2);
        const int col0 = (u.pn & 3) * 256 + wc * 32 + 4 * fq;
#pragma unroll
        for (int ai = 0; ai < 2; ++ai)
#pragma unroll
            for (int m = 0; m < 4; ++m) { bf16* dst = o + ((size_t)u.pm * 256 + ai * 128 + wr * 64 + m * 16 + fr) * D + col0;
#pragma unroll
                for (int bj = 0; bj < 2; ++bj)
#pragma unroll
                    for (int n = 0; n < 2; ++n) { f32x4 x = acc[ai][bj][m][n]; if (sec == 0) { x.x = siluf(x.x); x.y = siluf(x.y); x.z = siluf(x.z); x.w = siluf(x.w); }
                        v2u pk; pk.x = pk2(x.x, x.y); pk.y = pk2(x.z, x.w); *(v2u*)(dst + bj * 128 + n * 16) = pk; } }
    }
};

constexpr int G_ROW = 272;
constexpr int G_TROW = 144;
constexpr int GL_QT = 0, GL_QD = GL_QT + 64 * G_ROW, GL_KD = GL_QD + 64 * G_ROW, GL_KT = GL_KD + 64 * G_ROW, GL_V = GL_KT + 64 * G_ROW;
constexpr int GL_QO = GL_V + 64 * G_ROW, GL_KO = GL_QO + 32 * G_ROW;
constexpr int GL_P = GL_KO + 32 * G_ROW;
constexpr int GL_TOT = GL_P + 64 * G_TROW;
constexpr int GL_DEC = GL_TOT + 8 * 128 * 4;
constexpr int GL_END = GL_DEC + 512;
static_assert(GL_END <= RING_BYTES, "gla LDS");
typedef short v4i16_t __attribute__((ext_vector_type(4)));
__device__ __forceinline__ bf16x8 tr_frag(const LAS unsigned char* p) {
    const v4i16_t a = __builtin_amdgcn_ds_read_tr16_b64_v4i16((LAS v4i16_t*)p), b = __builtin_amdgcn_ds_read_tr16_b64_v4i16((LAS v4i16_t*)(p + 4 * G_ROW));
    return (bf16x8){a[0], a[1], a[2], a[3], b[0], b[1], b[2], b[3]};
}
constexpr float L2E = 1.4426950408889634f;

__device__ __forceinline__ void gla_chain(Frame& F, int b, int h, int dir) {
    const int tid = F.tid, lane = F.lane, wid = F.wave, l15 = lane & 15, g4 = lane >> 4;
    LAS unsigned char* lds = F.lds;
    const bf16* QH = (const bf16*)(F.ws + WS_QH); const bf16* VH = (const bf16*)(F.ws + WS_VH); const bf16* ZZ = (const bf16*)(F.ws + (dir ? WS_ZB : WS_ZF));
    bf16* OUT = (bf16*)(F.ws + (dir ? WS_OB : WS_H));
    const float* lbp = (const float*)(F.ws + WS_LB) + dir * 1024 + h * 128;
    const int kp = tid & 63, tb = tid >> 6;
    const float lb0 = lbp[2 * kp], lb1 = lbp[2 * kp + 1];
    const int srow = tid >> 3, sch = tid & 7;
    f32x4 S[8];
#pragma unroll
    for (int i = 0; i < 8; ++i) S[i] = (f32x4){0.f, 0.f, 0.f, 0.f};
    for (int i = tid; i < 64 * G_TROW / 4; i += 512) ((LAS unsigned*)(lds + GL_P))[i] = 0u;
#define GLA_ROWBASE(c) (((c) < 4) ? (NLAT + b * TCX + (dir ? (3 - (c)) : (c)) * 64) : (b * TL + (dir ? (35 - (c)) : ((c) - 4)) * 64))
    unsigned zr[8], qr[8]; v4u vr0, vr1;
#define GLA_LOAD(c) do { const int rb_ = GLA_ROWBASE(c); \
        _Pragma("unroll") for (int i = 0; i < 8; ++i) { const int tau_ = 8 * tb + i; const size_t o_ = (size_t)(rb_ + (dir ? 63 - tau_ : tau_)) * D + h * 128 + 2 * kp; \
            zr[i] = *(const unsigned*)(ZZ + o_); qr[i] = ((c) >= 4) ? *(const unsigned*)(QH + o_) : 0u; } \
        const size_t ov_ = (size_t)(rb_ + (dir ? 63 - srow : srow)) * D + h * 128 + sch * 8; vr0 = *(const v4u*)(VH + ov_); vr1 = *(const v4u*)(VH + ov_ + 64); } while (0)
    GLA_LOAD(0);
    for (int c = 0; c < 36; ++c) {
        const bool isctx = c < 4;
        const int rowbase = GLA_ROWBASE(c);
        *(LAS v4u*)(lds + GL_V + srow * G_ROW + sch * 16) = vr0; *(LAS v4u*)(lds + GL_V + srow * G_ROW + 128 + sch * 16) = vr1;
        float lf0[8], lf1[8], kk0[8], kk1[8], q0[8], q1[8];
        float s0 = 0.f, s1 = 0.f;
#pragma unroll
        for (int i = 0; i < 8; ++i) {
            const float za = bflo(zr[i]), zb = bfhi(zr[i]);
            kk0[i] = (1.f - lb0) * __builtin_amdgcn_rcpf(1.f + __builtin_amdgcn_exp2f(za * L2E));
            kk1[i] = (1.f - lb1) * __builtin_amdgcn_rcpf(1.f + __builtin_amdgcn_exp2f(zb * L2E));
            s0 += __builtin_amdgcn_logf(1.f - kk0[i]); s1 += __builtin_amdgcn_logf(1.f - kk1[i]); lf0[i] = s0; lf1[i] = s1;
            q0[i] = bflo(qr[i]); q1[i] = bfhi(qr[i]); }
        *(LAS float*)(lds + GL_TOT + (tb * 128 + 2 * kp) * 4) = s0; *(LAS float*)(lds + GL_TOT + (tb * 128 + 2 * kp + 1) * 4) = s1;
        __syncthreads();
        if (c + 1 < 36) GLA_LOAD(c + 1);
        {
            float pre0 = 0.f, pre1 = 0.f, c15_0 = 0.f, c15_1 = 0.f, c31_0 = 0.f, c31_1 = 0.f, c47_0 = 0.f, c47_1 = 0.f, c63_0 = 0.f, c63_1 = 0.f;
#pragma unroll
            for (int j = 0; j < 8; ++j) { const float t0 = *(const LAS float*)(lds + GL_TOT + (j * 128 + 2 * kp) * 4), t1 = *(const LAS float*)(lds + GL_TOT + (j * 128 + 2 * kp + 1) * 4);
                pre0 += (j < tb) ? t0 : 0.f; pre1 += (j < tb) ? t1 : 0.f;
                c63_0 += t0; c63_1 += t1;
                if (j < 2) { c15_0 += t0; c15_1 += t1; } if (j < 4) { c31_0 += t0; c31_1 += t1; } if (j < 6) { c47_0 += t0; c47_1 += t1; } }
            const bool blkA = tb < 4;
            const float m0 = blkA ? c15_0 : c47_0, m1 = blkA ? c15_1 : c47_1;
            const float em0 = __builtin_amdgcn_exp2f(m0), em1 = __builtin_amdgcn_exp2f(m1);
            const float ek0 = __builtin_amdgcn_exp2f(c63_0 - m0), ek1 = __builtin_amdgcn_exp2f(c63_1 - m1);
            const float eo0 = __builtin_amdgcn_exp2f(blkA ? c31_0 - m0 : m0 - c31_0), eo1 = __builtin_amdgcn_exp2f(blkA ? c31_1 - m1 : m1 - c31_1);
#pragma unroll
            for (int i = 0; i < 8; ++i) { const int tau = 8 * tb + i; const float d0 = pre0 + lf0[i] - m0, d1 = pre1 + lf1[i] - m1;
                const float qd0 = q0[i] * __builtin_amdgcn_exp2f(d0), qd1 = q1[i] * __builtin_amdgcn_exp2f(d1);
                const float kd0 = kk0[i] * __builtin_amdgcn_exp2f(fminf(-d0, 126.f)), kd1 = kk1[i] * __builtin_amdgcn_exp2f(fminf(-d1, 126.f));
                *(LAS unsigned*)(lds + GL_QD + tau * G_ROW + kp * 4) = pk2(qd0, qd1);
                *(LAS unsigned*)(lds + GL_KD + tau * G_ROW + kp * 4) = pk2(kd0, kd1);
                *(LAS unsigned*)(lds + GL_QT + tau * G_ROW + kp * 4) = pk2(qd0 * em0, qd1 * em1);
                *(LAS unsigned*)(lds + GL_KT + tau * G_ROW + kp * 4) = pk2(kd0 * ek0, kd1 * ek1);
                if (blkA) *(LAS unsigned*)(lds + GL_KO + tau * G_ROW + kp * 4) = pk2(kd0 * eo0, kd1 * eo1);
                else *(LAS unsigned*)(lds + GL_QO + (tau - 32) * G_ROW + kp * 4) = pk2(qd0 * eo0, qd1 * eo1); }
            if (tb == 0) { *(LAS float*)(lds + GL_DEC + (2 * kp) * 4) = __builtin_amdgcn_exp2f(c63_0); *(LAS float*)(lds + GL_DEC + (2 * kp + 1) * 4) = __builtin_amdgcn_exp2f(c63_1); }
        }
        __syncthreads();
        if (!isctx) {
            for (int ti = wid; ti < 10; ti += 8) {
                const int tt = ti == 0 ? 0 : ti == 1 ? 1 : ti == 2 ? 1 : ti == 3 ? 2 : ti == 4 ? 3 : ti == 5 ? 3 : ti == 6 ? 2 : ti == 7 ? 2 : 3;
                const int st = ti == 0 ? 0 : ti == 1 ? 0 : ti == 2 ? 1 : ti == 3 ? 2 : ti == 4 ? 2 : ti == 5 ? 3 : ti == 6 ? 0 : ti == 7 ? 1 : ti == 8 ? 0 : 1;
                const bool offd = ti >= 6;
                const LAS unsigned char* qa = offd ? lds + GL_QO + ((tt - 2) * 16 + l15) * G_ROW : lds + GL_QD + (tt * 16 + l15) * G_ROW;
                const LAS unsigned char* ka = offd ? lds + GL_KO + (st * 16 + l15) * G_ROW : lds + GL_KD + (st * 16 + l15) * G_ROW;
                f32x4 a = (f32x4){0.f, 0.f, 0.f, 0.f};
#pragma unroll
                for (int ks = 0; ks < 4; ++ks) { const bf16x8 af = *(const LAS bf16x8*)(qa + ks * 64 + g4 * 16), bfr = *(const LAS bf16x8*)(ka + ks * 64 + g4 * 16);
                    a = __builtin_amdgcn_mfma_f32_16x16x32_bf16(af, bfr, a, 0, 0, 0); }
#pragma unroll
                for (int rg = 0; rg < 4; ++rg) { const int tl = 4 * g4 + rg; float v = a[rg]; if (tt == st && l15 > tl) v = 0.f;
                    *(LAS unsigned short*)(lds + GL_P + (tt * 16 + tl) * G_TROW + (st * 16 + l15) * 2) = (unsigned short)(pk2(v, 0.f) & 0xffffu); }
            }
        }
        bf16x8 vf[2];
#pragma unroll
        for (int ks = 0; ks < 2; ++ks) vf[ks] = tr_frag(lds + GL_V + (32 * ks + 8 * g4 + (l15 >> 2)) * G_ROW + (16 * wid + 4 * (l15 & 3)) * 2);
        f32x4 oacc[4];
        if (!isctx) {
            bf16x8 sb[4];
#pragma unroll
            for (int ks = 0; ks < 4; ++ks) { v4u w; w.x = pk2(S[2 * ks][0], S[2 * ks][1]); w.y = pk2(S[2 * ks][2], S[2 * ks][3]); w.z = pk2(S[2 * ks + 1][0], S[2 * ks + 1][1]); w.w = pk2(S[2 * ks + 1][2], S[2 * ks + 1][3]); sb[ks] = __builtin_bit_cast(bf16x8, w); }
#pragma unroll
            for (int tt = 0; tt < 4; ++tt) { f32x4 a = (f32x4){0.f, 0.f, 0.f, 0.f};
#pragma unroll
                for (int ks = 0; ks < 4; ++ks) { const LAS unsigned char* qp = lds + GL_QT + (tt * 16 + l15) * G_ROW + ks * 64 + g4 * 8;
                    const v2u x0 = *(const LAS v2u*)qp, x1 = *(const LAS v2u*)(qp + 32); v4u w; w.x = x0.x; w.y = x0.y; w.z = x1.x; w.w = x1.y;
                    a = __builtin_amdgcn_mfma_f32_16x16x32_bf16(__builtin_bit_cast(bf16x8, w), sb[ks], a, 0, 0, 0); }
                oacc[tt] = a; }
        }
#pragma unroll
        for (int kt = 0; kt < 8; ++kt) { const f32x4 dc = *(const LAS f32x4*)(lds + GL_DEC + (kt * 16 + 4 * g4) * 4);
            f32x4 a = S[kt] * dc;
#pragma unroll
            for (int ks = 0; ks < 2; ++ks) { const bf16x8 kf = tr_frag(lds + GL_KT + (32 * ks + 8 * g4 + (l15 >> 2)) * G_ROW + (16 * kt + 4 * (l15 & 3)) * 2);
                a = __builtin_amdgcn_mfma_f32_16x16x32_bf16(kf, vf[ks], a, 0, 0, 0); }
            S[kt] = a; }
        __syncthreads();
        if (!isctx) {
#pragma unroll
            for (int tt = 0; tt < 4; ++tt) { f32x4 a = oacc[tt];
#pragma unroll
                for (int ks = 0; ks < 2; ++ks) { const bf16x8 pf = *(const LAS bf16x8*)(lds + GL_P + (tt * 16 + l15) * G_TROW + ks * 64 + g4 * 16);
                    a = __builtin_amdgcn_mfma_f32_16x16x32_bf16(pf, vf[ks], a, 0, 0, 0); }
#pragma unroll
                for (int rg = 0; rg < 4; ++rg) { const int tau = tt * 16 + 4 * g4 + rg; const int orow = rowbase + (dir ? (63 - tau) : tau);
                    OUT[(size_t)orow * D + h * 128 + wid * 16 + l15] = (bf16)(pk2(a[rg], 0.f) & 0xffffu); } }
        }
        __syncthreads();
    }
#undef GLA_LOAD
#undef GLA_ROWBASE
}
__device__ __forceinline__ void p_gla(Frame& F) {
    for (int u = F.vcu; u < 128; u += F.G) gla_chain(F, u >> 4, (u >> 1) & 7, u & 1);
    if (F.vcu >= 128) {
        const int nw = (F.G - 128) * NWAVES;
        for (int it = (F.vcu - 128) * NWAVES + F.wave; it < MOE_ITEMS; it += nw) p0_moe_item(F, 1, it);
    }
}

__device__ __forceinline__ void p_readout(Frame& F) {
    const int gw = F.vcu * NWAVES + F.wave, NGW = F.G * NWAVES, lane = F.lane;
    bf16* OF = (bf16*)(F.ws + WS_H); const bf16* OB = (const bf16*)(F.ws + WS_OB); const bf16* GH = (const bf16*)(F.ws + WS_GH);
    const float* on = F.in[I_ONORM];
    for (int r = gw; r < NLAT; r += NGW) {
#pragma unroll
        for (int half = 0; half < 2; ++half) {
            const size_t off = (size_t)r * D + half * 512 + lane * 8;
            const v4u a = *(const v4u*)(OF + off), b2 = *(const v4u*)(OB + off), gg = *(const v4u*)(GH + off);
            float o[8]; const unsigned au[4] = {a.x, a.y, a.z, a.w}, bu[4] = {b2.x, b2.y, b2.z, b2.w}, gu[4] = {gg.x, gg.y, gg.z, gg.w};
            float ss = 0.f;
#pragma unroll
            for (int j = 0; j < 4; ++j) { o[2 * j] = bflo(au[j]) + bflo(bu[j]); o[2 * j + 1] = bfhi(au[j]) + bfhi(bu[j]); ss += o[2 * j] * o[2 * j] + o[2 * j + 1] * o[2 * j + 1]; }
            ss += __shfl_xor(ss, 1); ss += __shfl_xor(ss, 2); ss += __shfl_xor(ss, 4); ss += __shfl_xor(ss, 8);
            const float rstd = 1.0f / sqrtf(ss * (1.f / 128.f) + EPS);
            const int d0 = (lane & 15) * 8;
            unsigned w[4];
#pragma unroll
            for (int j = 0; j < 4; ++j) { const float g0 = bflo(gu[j]), g1 = bfhi(gu[j]);
                w[j] = pk2(o[2 * j] * rstd * on[d0 + 2 * j] * siluf(g0), o[2 * j + 1] * rstd * on[d0 + 2 * j + 1] * siluf(g1)); }
            *(v4u*)(OF + off) = (v4u){w[0], w[1], w[2], w[3]};
        }
    }
}

struct Args { const float* in[23]; float* out; unsigned char* ws; int ph_lo, ph_hi; };
constexpr int N_PHASES = 17;
__global__ void __launch_bounds__(NWAVES * 64, 2) fwd_mega(Args args) {
    extern __shared__ __attribute__((aligned(16))) unsigned char lds[];
    Frame F;
    F.lds = (LAS unsigned char*)lds;
    F.MISC = (volatile LAS unsigned*)(F.lds + MISC_OFF);
    F.tid = threadIdx.x; F.lane = F.tid & 63; F.wave = __builtin_amdgcn_readfirstlane(F.tid >> 6);
    F.G = gridDim.x; { const int bx = blockIdx.x; F.vcu = (F.G % 8 == 0) ? (bx % 8) * (F.G / 8) + bx / 8 : bx; }
    F.ws = args.ws; F.ctl = (gu32*)(args.ws + WS_CTL); F.out = args.out;
#pragma unroll
    for (int i = 0; i < 23; ++i) F.in[i] = args.in[i];
    for (int u = F.tid; u < (LDS_BYTES - LDSCTL_OFF) / 4; u += NWAVES * 64) ((LAS unsigned*)(F.lds + LDSCTL_OFF))[u] = 0u;
    __syncthreads();
    XcdBarrier bar; bar.bar = (unsigned*)(F.ctl + CW_BAR); bar.x = 0; bar.st = nullptr;
    if (!MK_PER_PHASE) bar = xcd_barrier_post((unsigned*)(F.ctl + CW_BAR), F.MISC + 8);
    const int lo = args.ph_lo, hi = args.ph_hi;
#ifdef MK_ONLY
#define IN(k) ((k) == MK_ONLY && lo <= (k) && (k) < hi)
#else
#define IN(k) (lo <= (k) && (k) < hi)
#endif
#ifndef MK_PROBE
#define MK_PROBE 0
#endif
#if MK_PROBE
#define STAMP(k) do { if (F.tid == 0) F.MISC[64 + (k)] = (unsigned)__builtin_amdgcn_s_memrealtime(); } while (0)
#define SEAM(k) do { if (IN((k) + 1) || (k) == 16) xcd_barrier(bar); STAMP((k) + 1); } while (0)
#else
#define STAMP(k) do { } while (0)
#define SEAM(k) do { if (IN((k) + 1)) xcd_barrier(bar); } while (0)
#endif
    STAMP(0);
    const float* modp = (const float*)(F.ws + WS_MOD);
    if (IN(0)) { p0_prep(F); SEAM(0); }
    if (IN(1)) { p_norm_mix0(F); SEAM(1); }
    if (IN(2)) {
        pg8::Gemm g{(const bf16*)(F.ws + WS_H), (const bf16*)(F.ws + WS_WQKV), D, nullptr}; pg8::StaticOrder S; S.init(NR, 3072, F.G, (int)blockIdx.x);
        EpiQKV E{(bf16*)(F.ws + WS_Q), (bf16*)(F.ws + WS_K), (bf16*)(F.ws + WS_VT), F.in[I_QN], F.in[I_KN], (const float*)(F.ws + WS_ROPE), (const float*)(F.ws + WS_ROPE) + 2048 * 32};
        pg8::gemm_phase<EpiQKV, pg8::StaticOrder, false>(F.lds + RING_OFF, g, S, E); SEAM(2); }
    if (IN(3)) { p_attention(F); SEAM(3); }
    if (IN(4)) {
        pg8::Gemm g{(const bf16*)(F.ws + WS_AO), (const bf16*)(F.ws + WS_WO), D, nullptr}; pg8::StaticOrder S; S.init(NR, D, F.G, (int)blockIdx.x);
        EpiResid E{F.in[I_X], F.out, F.in[I_CTX], (float*)(F.ws + WS_XC), modp + 2048};
        pg8::gemm_phase<EpiResid, pg8::StaticOrder, false>(F.lds + RING_OFF, g, S, E); SEAM(4); }
    if (IN(5)) { p_ffn_router(F, 0, NR); SEAM(5); }
    if (IN(6)) {
        MoeOrder S; S.setup(F, 0, 4);
        pg8::Gemm g{(const bf16*)(F.ws + WS_H), (const bf16*)(F.ws + WS_WGU), D, (const int*)(F.ws + WS_LIST)};
        EpiGateUp E{(bf16*)(F.ws + WS_HID)};
        pg8::gemm_phase<EpiGateUp, MoeOrder, true>(F.lds + RING_OFF, g, S, E); SEAM(6); }
    if (IN(7)) {
        MoeOrder S; S.setup(F, 0, 4);
        pg8::Gemm g{(const bf16*)(F.ws + WS_HID), (const bf16*)(F.ws + WS_WD), DFF, nullptr};
        EpiDown E{(bf16*)(F.ws + WS_YC), (const int*)(F.ws + WS_LIST), (const float*)(F.ws + WS_WGT)};
        pg8::gemm_phase<EpiDown, MoeOrder, false>(F.lds + RING_OFF, g, S, E); SEAM(7); }
    if (IN(8)) {
        p_combine(F, 0, NR, true);
        SEAM(8); }
    if (IN(9)) {
        pg8::Gemm g{(const bf16*)(F.ws + WS_H), (const bf16*)(F.ws + WS_WIN), D, nullptr}; pg8::StaticOrder S; S.init(NR, 5120, F.G, (int)blockIdx.x);
        EpiWin E{(bf16*)(F.ws + WS_QH)};
        pg8::gemm_phase<EpiWin, pg8::StaticOrder, false>(F.lds + RING_OFF, g, S, E); SEAM(9); }
    if (IN(10)) { p_gla(F); SEAM(10); }
    if (IN(11)) { p_readout(F); SEAM(11); }
    if (IN(12)) {
        pg8::Gemm g{(const bf16*)(F.ws + WS_H), (const bf16*)(F.ws + WS_WO2), D, nullptr}; pg8::StaticOrder S; S.init(NLAT, D, F.G, (int)blockIdx.x);
        EpiResid E{F.out, F.out, nullptr, nullptr, modp + 9 * 6144 + 2048};
        pg8::gemm_phase<EpiResid, pg8::StaticOrder, false>(F.lds + RING_OFF, g, S, E); SEAM(12); }
    if (IN(13)) { p_ffn_router(F, 1, NLAT); SEAM(13); }
    if (IN(14)) {
        MoeOrder S; S.setup(F, 1, 4);
        pg8::Gemm g{(const bf16*)(F.ws + WS_H), (const bf16*)(F.ws + WS_WGU), D, (const int*)(F.ws + WS_LIST)};
        EpiGateUp E{(bf16*)(F.ws + WS_HID)};
        pg8::gemm_phase<EpiGateUp, MoeOrder, true>(F.lds + RING_OFF, g, S, E); SEAM(14); }
    if (IN(15)) {
        MoeOrder S; S.setup(F, 1, 4);
        pg8::Gemm g{(const bf16*)(F.ws + WS_HID), (const bf16*)(F.ws + WS_WD), DFF, nullptr};
        EpiDown E{(bf16*)(F.ws + WS_YC), (const int*)(F.ws + WS_LIST), (const float*)(F.ws + WS_WGT)};
        pg8::gemm_phase<EpiDown, MoeOrder, false>(F.lds + RING_OFF, g, S, E); SEAM(15); }
    if (IN(16)) { p_combine(F, 1, NLAT, false); SEAM(16); }
#if MK_PROBE
    {
        __syncthreads();
        const float ta = (float)(F.MISC[64 + MK_PA1] - F.MISC[64 + MK_PA0]) * 0.01f, tb = (float)(F.MISC[64 + MK_PB1] - F.MISC[64 + MK_PB0]) * 0.01f;
        float* o = F.out + (size_t)(1 + 4 * blockIdx.x) * D;
        for (int i = F.tid; i < 4 * D; i += 512) o[i] += tb * 0.01f;
        if (blockIdx.x == 0 && F.tid == 0) F.out[0] = 2.0f * ta;
    }
#endif
#undef IN
#undef SEAM
}

extern "C" void kernel_launch(void* const* d_in, const int* in_sizes, int n_in, void* d_out, int out_size, void* d_ws, size_t ws_size, hipStream_t stream) {
    static int grid = 0;
    if (grid == 0) {
        if (n_in != 23 || out_size != NLAT * D || ws_size < WS_END) { fprintf(stderr, "kernel_launch: unexpected problem (n_in %d, out %d, ws %zu)\n", n_in, out_size, ws_size); grid = -1; return; }
        int dev = 0, cus = 0, per_cu = 0;
        if (hipGetDevice(&dev) != hipSuccess || hipDeviceGetAttribute(&cus, hipDeviceAttributeMultiprocessorCount, dev) != hipSuccess) { grid = -1; return; }
        if (hipFuncSetAttribute((const void*)fwd_mega, hipFuncAttributeMaxDynamicSharedMemorySize, LDS_BYTES) != hipSuccess) { fprintf(stderr, "kernel_launch: hipFuncSetAttribute failed\n"); grid = -1; return; }
        if (hipOccupancyMaxActiveBlocksPerMultiprocessor(&per_cu, (const void*)fwd_mega, NWAVES * 64, LDS_BYTES) != hipSuccess || per_cu < 1) fprintf(stderr, "kernel_launch: occupancy query reports %d\n", per_cu);
        (void)hipGetLastError();
        grid = cus;
    }
    if (grid < 0) return;
    if (hipMemsetAsync((char*)d_ws + WS_CTL, 0, CTL_ZERO_BYTES, stream) != hipSuccess) return;
    Args a{};
    for (int i = 0; i < 23; ++i) a.in[i] = (const float*)d_in[i];
    a.out = (float*)d_out; a.ws = (unsigned char*)d_ws;
    const int last = MK_STOP_AFTER < N_PHASES - 1 ? MK_STOP_AFTER : N_PHASES - 1;
#if MK_PER_PHASE
    for (int p = 0; p <= last; ++p) { a.ph_lo = p; a.ph_hi = p + 1; hipLaunchKernelGGL(fwd_mega, dim3(grid), dim3(NWAVES * 64), LDS_BYTES, stream, a); }
#elif defined(MK_DUP)
    a.ph_lo = 0; a.ph_hi = MK_DUP + 1;
    hipLaunchKernelGGL(fwd_mega, dim3(grid), dim3(NWAVES * 64), LDS_BYTES, stream, a);
    if (MK_DUP == 6 || MK_DUP == 7 || MK_DUP == 14 || MK_DUP == 15) (void)hipMemsetAsync((char*)d_ws + WS_CTL + CW_BAR * 4, 0, 3456 * 4, stream);
    else (void)hipMemsetAsync((char*)d_ws + WS_CTL, 0, CTL_ZERO_BYTES, stream);
    a.ph_lo = MK_DUP; a.ph_hi = last + 1;
    hipLaunchKernelGGL(fwd_mega, dim3(grid), dim3(NWAVES * 64), LDS_BYTES, stream, a);
#else
    a.ph_lo = 0; a.ph_hi = last + 1;
    hipLaunchKernelGGL(fwd_mega, dim3(grid), dim3(NWAVES * 64), LDS_BYTES, stream, a);
#endif
}
```
